# Optimizing an MI355X kernel written in HIP

```python
import jax, jax.numpy as jnp
from jax import lax
import numpy as np

D_MODEL = 1024
BATCH = 8
SEQ = 4096
DEPTH = 4

N_MIXERS = 2
N_POOL_LAYERS = (DEPTH + 1) // 2
N_MLA_LAYERS = DEPTH // 2

POOL_WINDOWS = (2, 4, 8, 16)
N_POOL_GROUPS = len(POOL_WINDOWS)
POOL_GROUP = D_MODEL // N_POOL_GROUPS

N_HEADS = D_MODEL // 128
QK_NOPE_DIM = 128
QK_ROPE_DIM = 64
V_HEAD_DIM = 128
Q_LORA_RANK = 3 * D_MODEL // 8
KV_LORA_RANK = D_MODEL // 8
QK_HEAD_DIM = QK_NOPE_DIM + QK_ROPE_DIM
ROPE_THETA = 10000.0
Q_BLOCK = 128

D_FF = ((8 * D_MODEL // 3 + 255) // 256) * 256

RMS_EPS = 1e-6

kernel_name = "hybrid_pool_mla_swiglu_trunk"


def rms_norm(x, g):
    xf = x.astype(jnp.float32)
    y = xf * lax.rsqrt(jnp.mean(xf * xf, axis=-1, keepdims=True) + RMS_EPS)
    return (y * g.astype(jnp.float32)).astype(x.dtype)


def pool_mixer(h, w, scale):
    B, S, D = h.shape
    hf = h.astype(jnp.float32).reshape(B, S, N_POOL_GROUPS, POOL_GROUP)
    cs = jnp.cumsum(hf, axis=1)
    n_avail = jnp.arange(1, S + 1, dtype=jnp.float32)
    outs = []
    for g, win in enumerate(POOL_WINDOWS):
        c = cs[:, :, g]
        lag = jnp.pad(c[:, :-win], ((0, 0), (win, 0), (0, 0)))
        mean = (c - lag) / jnp.minimum(n_avail, float(win))[:, None]
        outs.append(mean - hf[:, :, g])
    p = jnp.stack(outs, axis=2).astype(h.dtype)
    y = jnp.einsum('bsgc,gcd->bsgd', p, w).reshape(B, S, D)
    return y * scale


def rope_tables(positions):
    inv = 1.0 / (ROPE_THETA ** (jnp.arange(0, QK_ROPE_DIM, 2, dtype=jnp.float32) / QK_ROPE_DIM))
    ang = positions.astype(jnp.float32)[..., None] * inv
    return jnp.cos(ang), jnp.sin(ang)


def apply_rope(x, cos, sin):
    xf = x.astype(jnp.float32)
    half = QK_ROPE_DIM // 2
    x1, x2 = xf[..., :half], xf[..., half:]
    return jnp.concatenate([x1 * cos - x2 * sin, x2 * cos + x1 * sin], axis=-1).astype(x.dtype)


def causal_attention(q, k, v):
    B, S, H, Dq = q.shape
    nb = S // Q_BLOCK
    qb = q.reshape(B, nb, Q_BLOCK, H, Dq).transpose(1, 0, 2, 3, 4)
    key_pos = jnp.arange(S)
    sm_scale = Dq ** -0.5

    def one_block(args):
        blk, qi = args
        s = jnp.einsum('bqhd,bkhd->bhqk', qi, k).astype(jnp.float32) * sm_scale
        q_pos = blk * Q_BLOCK + jnp.arange(Q_BLOCK)
        mask = key_pos[None, :] <= q_pos[:, None]
        s = jnp.where(mask, s, -jnp.inf)
        p = jax.nn.softmax(s, axis=-1).astype(v.dtype)
        return jnp.einsum('bhqk,bkhd->bqhd', p, v)

    o = lax.map(one_block, (jnp.arange(nb), qb))
    return o.transpose(1, 0, 2, 3, 4).reshape(B, S, H, v.shape[-1])


def mla(h, cos, sin, w_down, q_norm, w_uq, kv_norm, w_ukv, w_o):
    B, S, _ = h.shape
    d = h @ w_down
    cq = rms_norm(d[..., :Q_LORA_RANK], q_norm)
    ckv = rms_norm(d[..., Q_LORA_RANK:Q_LORA_RANK + KV_LORA_RANK], kv_norm)
    k_rope = apply_rope(d[..., Q_LORA_RANK + KV_LORA_RANK:], cos, sin)
    q = (cq @ w_uq).reshape(B, S, N_HEADS, QK_HEAD_DIM)
    q_rope = apply_rope(q[..., QK_NOPE_DIM:], cos[:, :, None], sin[:, :, None])
    q = jnp.concatenate([q[..., :QK_NOPE_DIM], q_rope], axis=-1)
    kv = (ckv @ w_ukv).reshape(B, S, N_HEADS, QK_NOPE_DIM + V_HEAD_DIM)
    k = jnp.concatenate(
        [kv[..., :QK_NOPE_DIM],
         jnp.broadcast_to(k_rope[:, :, None, :], (B, S, N_HEADS, QK_ROPE_DIM))], axis=-1)
    v = kv[..., QK_NOPE_DIM:]
    o = causal_attention(q, k, v)
    return o.reshape(B, S, N_HEADS * V_HEAD_DIM) @ w_o


def swiglu(h, w_gate, w_up, w_down):
    return (jax.nn.silu(h @ w_gate) * (h @ w_up)) @ w_down


def setup_inputs(seed: int = 0) -> dict:
    key = jax.random.key(seed)
    ks = jax.random.split(key, 16)
    f32 = jnp.float32

    def nrm(k, shape, fan_in):
        return jax.random.normal(k, shape, f32) * (fan_in ** -0.5)

    def gain(k, shape):
        return 1.0 + 0.02 * jax.random.normal(k, shape, f32)

    x = jax.random.normal(ks[0], (BATCH, SEQ, D_MODEL), f32)
    positions = jnp.broadcast_to(jnp.arange(SEQ, dtype=jnp.int32)[None, :], (BATCH, SEQ))
    return {
        "x": x,
        "positions": positions,
        "norm_mix": gain(ks[1], (DEPTH, D_MODEL)),
        "norm_ffn": gain(ks[2], (DEPTH, D_MODEL)),
        "norm_final": gain(ks[3], (D_MODEL,)),
        "pool_w": nrm(ks[4], (N_POOL_LAYERS, N_POOL_GROUPS, POOL_GROUP, POOL_GROUP), POOL_GROUP),
        "pool_scale": gain(ks[5], (N_POOL_LAYERS, D_MODEL)),
        "mla_w_down": nrm(ks[6], (N_MLA_LAYERS, D_MODEL, Q_LORA_RANK + KV_LORA_RANK + QK_ROPE_DIM), D_MODEL),
        "mla_q_norm": gain(ks[7], (N_MLA_LAYERS, Q_LORA_RANK)),
        "mla_w_uq": nrm(ks[8], (N_MLA_LAYERS, Q_LORA_RANK, N_HEADS * QK_HEAD_DIM), Q_LORA_RANK),
        "mla_kv_norm": gain(ks[9], (N_MLA_LAYERS, KV_LORA_RANK)),
        "mla_w_ukv": nrm(ks[10], (N_MLA_LAYERS, KV_LORA_RANK, N_HEADS * (QK_NOPE_DIM + V_HEAD_DIM)), KV_LORA_RANK),
        "mla_w_o": nrm(ks[11], (N_MLA_LAYERS, N_HEADS * V_HEAD_DIM, D_MODEL), N_HEADS * V_HEAD_DIM),
        "ffn_w_gate": nrm(ks[12], (DEPTH, D_MODEL, D_FF), D_MODEL),
        "ffn_w_up": nrm(ks[13], (DEPTH, D_MODEL, D_FF), D_MODEL),
        "ffn_w_down": nrm(ks[14], (DEPTH, D_FF, D_MODEL), D_FF),
    }


def reference(x, positions, norm_mix, norm_ffn, norm_final, pool_w, pool_scale,
              mla_w_down, mla_q_norm, mla_w_uq, mla_kv_norm, mla_w_ukv, mla_w_o,
              ffn_w_gate, ffn_w_up, ffn_w_down):
    cos, sin = rope_tables(positions)
    for i in range(DEPTH):
        h = rms_norm(x, norm_mix[i])
        j = i // N_MIXERS
        if i % N_MIXERS == 0:
            x = x + pool_mixer(h, pool_w[j], pool_scale[j])
        else:
            x = x + mla(h, cos, sin, mla_w_down[j], mla_q_norm[j], mla_w_uq[j],
                        mla_kv_norm[j], mla_w_ukv[j], mla_w_o[j])
        h = rms_norm(x, norm_ffn[i])
        x = x + swiglu(h, ffn_w_gate[i], ffn_w_up[i], ffn_w_down[i])
    return rms_norm(x, norm_final)
```

```cpp
#include <hip/hip_runtime.h>
#include <hip/hip_cooperative_groups.h>
#include <cstdio>
#include <cstdint>
namespace cg = cooperative_groups;

#ifndef MK_SINGLE
#define MK_SINGLE 1
#endif
#ifndef PROBE_MASK
#define PROBE_MASK 0
#define PROBE_REPS 2
#endif
#ifndef MK_DEBUG
#define MK_DEBUG 0
#endif
#ifndef DBG_IGNORE
#define DBG_IGNORE 0ull
#endif


typedef unsigned short bf16_t;
typedef short bf16x8 __attribute__((ext_vector_type(8)));
typedef short s16x4 __attribute__((ext_vector_type(4)));
typedef float f32x4 __attribute__((ext_vector_type(4)));
typedef float f32x16 __attribute__((ext_vector_type(16)));
typedef unsigned u32x4 __attribute__((ext_vector_type(4)));
typedef unsigned u32x2 __attribute__((ext_vector_type(2)));
#define LAS __attribute__((address_space(3)))

constexpr int T = 32768, DM = 1024, SEQ = 4096, FF = 2816;
constexpr float EPS = 1e-6f;

constexpr size_t OFF_WPOOL = 0;
constexpr size_t OFF_WMD   = OFF_WPOOL + (size_t)2 * 1024 * 256 * 2;
constexpr size_t OFF_WUQ   = OFF_WMD + (size_t)2 * 768 * 1024 * 2;
constexpr size_t OFF_WUKV  = OFF_WUQ + (size_t)2 * 1536 * 384 * 2;
constexpr size_t OFF_WO    = OFF_WUKV + (size_t)2 * 2048 * 256 * 2;
constexpr size_t OFF_WGU   = OFF_WO + (size_t)2 * 1024 * 1024 * 2;
constexpr size_t OFF_WDN   = OFF_WGU + (size_t)4 * 5632 * 1024 * 2;
constexpr size_t OFF_CTAB  = OFF_WDN + (size_t)4 * 1024 * 2816 * 2;
constexpr size_t OFF_STAB  = OFF_CTAB + (size_t)T * 32 * 4;
constexpr size_t OFF_H     = OFF_STAB + (size_t)T * 32 * 4;
constexpr size_t OFF_BIG   = OFF_H + (size_t)T * 1024 * 2;
constexpr size_t OFF_ACT   = OFF_BIG;
constexpr size_t OFF_D     = OFF_BIG;
constexpr size_t OFF_O     = OFF_BIG;
constexpr size_t OFF_KR    = OFF_BIG + (size_t)T * 1024 * 2;
constexpr size_t OFF_Q     = OFF_KR + (size_t)T * 64 * 2;
constexpr size_t OFF_KV    = OFF_Q + (size_t)T * 1536 * 2;

constexpr size_t OFF_PARTX = OFF_KV + (size_t)T * 2048 * 2;
constexpr size_t OFF_PARTD = OFF_PARTX + (size_t)T * 16 * 4;
constexpr size_t OFF_BAR   = OFF_PARTD + (size_t)T * 16 * 4;
constexpr size_t OFF_XB    = OFF_BAR + 16384;
constexpr size_t WS_END    = OFF_XB + (size_t)T * 1024 * 2;
static_assert(WS_END <= (size_t)536870912, "workspace");

constexpr int LDS_BYTES = 133120 + 64;

struct Params {
    const float* x; const int* pos; const float* norm_mix; const float* norm_ffn; const float* norm_final;
    const float* pool_w; const float* pool_scale; const float* w_down; const float* q_norm; const float* w_uq;
    const float* kv_norm; const float* w_ukv; const float* w_o; const float* w_gate; const float* w_up; const float* w_dn;
    float* out; unsigned char* ws; int ph_lo, ph_hi;
    unsigned char kind[32], layer[32], sub[32];
};

__device__ __forceinline__ unsigned cvtpk(float lo, float hi) {
    unsigned r; asm volatile("v_cvt_pk_bf16_f32 %0, %1, %2" : "=v"(r) : "v"(lo), "v"(hi)); return r;
}
__device__ __forceinline__ float bf2f(short v) { return __uint_as_float(((unsigned)(unsigned short)v) << 16); }
__device__ __forceinline__ bf16x8 pack8(f32x4 a, f32x4 b) {
    u32x4 w = {cvtpk(a[0], a[1]), cvtpk(a[2], a[3]), cvtpk(b[0], b[1]), cvtpk(b[2], b[3])};
    return *reinterpret_cast<bf16x8*>(&w);
}
__device__ __forceinline__ f32x4 ld4(const float* p) { return *(const f32x4*)p; }
__device__ __forceinline__ f32x4 ld4(const bf16_t* p) { const u32x2 w = *(const u32x2*)p; return f32x4{__uint_as_float(w.x << 16), __uint_as_float(w.x & 0xffff0000u), __uint_as_float(w.y << 16), __uint_as_float(w.y & 0xffff0000u)}; }
__device__ __forceinline__ float2 ld2(const float* p) { return *(const float2*)p; }
__device__ __forceinline__ float2 ld2(const bf16_t* p) { const unsigned w = *(const unsigned*)p; return make_float2(__uint_as_float(w << 16), __uint_as_float(w & 0xffff0000u)); }
__device__ __forceinline__ int opq_tid() { int t = threadIdx.x; asm volatile("" : "+v"(t)); return t; }
__device__ __forceinline__ int opq_bid() { int b = blockIdx.x; asm volatile("" : "+s"(b)); return b; }
__device__ __forceinline__ float wave_sum(float v) {
#pragma unroll
    for (int off = 32; off >= 1; off >>= 1) v += __shfl_xor(v, off);
    return v;
}

namespace pg8 {
constexpr int BM = 256, BK = 64, HALF = 128, HTB = HALF * BK * 2, NXCD = 8, WGM = 8;
__device__ __forceinline__ int lds_byte(int r, int c) { const int st = (r >> 4) * 2 + (c >> 5), rr = r & 15, cc = c & 31, ob = rr * 64 + cc * 2; return st * 1024 + (ob ^ (((ob >> 9) & 1) << 5)); }
__device__ __forceinline__ void stage_rc(int b, int& R, int& C) { const int st = b / 1024, sb = b % 1024, swz = sb ^ (((sb >> 9) & 1) << 5); R = (st >> 1) * 16 + swz / 64; C = (st & 1) * 32 + (swz % 64) / 2; }
__device__ __forceinline__ int perm32(int rho) { const int n = rho >> 4, i = rho & 15; return 8 * (i >> 2) + 4 * n + (i & 3); }
struct Unit { int pm, pn; };
struct Gemm { const bf16_t* A; const bf16_t* Bt; int M, N, K, lda, ldb, a_pn_off; };
struct StaticOrder {
    int nM, nN, nwg, G, c;
    __device__ void init(int M, int N, int G_, int c_) { nM = M / BM; nN = N / BM; nwg = nM * nN; G = G_; c = c_; }
    __device__ bool next(int i, Unit& u) const {
        const long L = (long)i * G + c; if (L >= nwg) return false;
        int wgid = (int)L; { const int q = nwg / NXCD, r = nwg % NXCD, xcd = wgid % NXCD, off = wgid / NXCD; wgid = (xcd < r ? xcd * (q + 1) : r * (q + 1) + (xcd - r) * q) + off; }
        const int nig = WGM * nN, gid = wgid / nig, fm = gid * WGM, gsz = (nM - fm) < WGM ? (nM - fm) : WGM;
        u.pm = fm + ((wgid % nig) % gsz); u.pn = (wgid % nig) / gsz; return true;
    }
};
__device__ __forceinline__ void rows_rstd(float (&rstd)[2][4], const float* part, int row0, int s0, int nq4, float invn, int fq) {
    f32x4 t[2][4]; const int q = fq < nq4 ? fq : nq4 - 1;
#pragma unroll
    for (int ai = 0; ai < 2; ++ai)
#pragma unroll
        for (int m = 0; m < 4; ++m) t[ai][m] = *(const f32x4*)(part + (size_t)(row0 + ai * HALF + m * 16) * 16 + s0 + q * 4);
#pragma unroll
    for (int ai = 0; ai < 2; ++ai)
#pragma unroll
        for (int m = 0; m < 4; ++m) { float ss = (t[ai][m][0] + t[ai][m][1]) + (t[ai][m][2] + t[ai][m][3]); ss = fq < nq4 ? ss : 0.f;
            ss += __shfl_xor(ss, 16); ss += __shfl_xor(ss, 32); rstd[ai][m] = rsqrtf(ss * invn + EPS); }
}
struct EpiResid {
    static constexpr bool PERM = false;
    const float* Rf; bf16_t* XB; float* PART;
    typedef int State;
    __device__ __forceinline__ void row_out(const f32x4 (&acc)[2][2][4][2], const f32x4 (&rv)[2][2], int ai, int m, int row, int col0, int slot, int fq) const {
        const size_t ro = (size_t)row * 1024 + col0; float ss = 0.f;
#pragma unroll
        for (int bj = 0; bj < 2; ++bj)
#pragma unroll
            for (int n = 0; n < 2; ++n) { const int cofs = bj * HALF + n * 16;
                const f32x4 v = acc[ai][bj][m][n] + rv[bj][n];
                ss += (v[0] * v[0] + v[1] * v[1]) + (v[2] * v[2] + v[3] * v[3]);
                u32x2 w = {cvtpk(v[0], v[1]), cvtpk(v[2], v[3])}; *(u32x2*)(XB + ro + cofs) = w; }
        ss += __shfl_xor(ss, 16); ss += __shfl_xor(ss, 32);
        if (fq == 0) PART[(size_t)row * 16 + slot] = ss;
    }
    __device__ __forceinline__ void operator()(const f32x4 (&acc)[2][2][4][2], const Unit& u, int wr, int wc, int fr, int fq, State&) const {
        const int row0 = u.pm * BM + wr * 64 + fr, col0 = u.pn * BM + wc * 32 + 4 * fq, slot = u.pn * 4 + wc;
        if (Rf) {
#pragma unroll
            for (int ai = 0; ai < 2; ++ai)
#pragma unroll
                for (int mp = 0; mp < 2; ++mp) { f32x4 rv[2][2][2];
#pragma unroll
                    for (int mm = 0; mm < 2; ++mm)
#pragma unroll
                        for (int bj = 0; bj < 2; ++bj)
#pragma unroll
                            for (int n = 0; n < 2; ++n) rv[mm][bj][n] = ld4(Rf + (size_t)(row0 + ai * HALF + (mp * 2 + mm) * 16) * 1024 + col0 + bj * HALF + n * 16);
#pragma unroll
                    for (int mm = 0; mm < 2; ++mm) row_out(acc, rv[mm], ai, mp * 2 + mm, row0 + ai * HALF + (mp * 2 + mm) * 16, col0, slot, fq); }
        } else {
#pragma unroll
            for (int ai = 0; ai < 2; ++ai) { u32x2 rw[4][2][2];
#pragma unroll
                for (int m = 0; m < 4; ++m)
#pragma unroll
                    for (int bj = 0; bj < 2; ++bj)
#pragma unroll
                        for (int n = 0; n < 2; ++n) rw[m][bj][n] = *(const u32x2*)(XB + (size_t)(row0 + ai * HALF + m * 16) * 1024 + col0 + bj * HALF + n * 16);
#pragma unroll
                for (int m = 0; m < 4; ++m) { f32x4 rv[2][2];
#pragma unroll
                    for (int bj = 0; bj < 2; ++bj)
#pragma unroll
                        for (int n = 0; n < 2; ++n) { const u32x2 w = rw[m][bj][n]; rv[bj][n] = f32x4{__uint_as_float(w.x << 16), __uint_as_float(w.x & 0xffff0000u), __uint_as_float(w.y << 16), __uint_as_float(w.y & 0xffff0000u)}; }
                    row_out(acc, rv, ai, m, row0 + ai * HALF + m * 16, col0, slot, fq); } }
        }
    }
};
struct EpiMdown {
    static constexpr bool PERM = false;
    bf16_t* D; bf16_t* KR; const float* PARTX; float* PARTD; const float* ctab; const float* stab;
    typedef int State;
    __device__ __forceinline__ void operator()(const f32x4 (&acc)[2][2][4][2], const Unit& u, int wr, int wc, int fr, int fq, State&) const {
        const int row0 = u.pm * BM + wr * 64 + fr, col0 = u.pn * BM + wc * 32 + 4 * fq;
        float rs[2][4]; rows_rstd(rs, PARTX, row0, 0, 4, 1.0f / 1024.0f, fq);
        const bool rope = (u.pn == 2) && (wc < 2); const int ri = wc * 16 + 4 * fq;
#pragma unroll
        for (int ai = 0; ai < 2; ++ai) {
            f32x4 csv[4], snv[4];
            if (rope) {
#pragma unroll
                for (int m = 0; m < 4; ++m) { const size_t to = (size_t)(row0 + ai * HALF + m * 16) * 32 + ri; csv[m] = *(const f32x4*)(ctab + to); snv[m] = *(const f32x4*)(stab + to); } }
#pragma unroll
            for (int m = 0; m < 4; ++m) { const int row = row0 + ai * HALF + m * 16; const float rstd = rs[ai][m];
                float s0 = 0.f, s1 = 0.f; f32x4 vv[2][2];
#pragma unroll
                for (int bj = 0; bj < 2; ++bj)
#pragma unroll
                    for (int n = 0; n < 2; ++n) { const int c = col0 + bj * HALF + n * 16; const f32x4 v = acc[ai][bj][m][n] * rstd; vv[bj][n] = v;
                        if (c < 640) { u32x2 w = {cvtpk(v[0], v[1]), cvtpk(v[2], v[3])}; *(u32x2*)(D + (size_t)row * 640 + c) = w; }
                        const float q = (v[0] * v[0] + v[1] * v[1]) + (v[2] * v[2] + v[3] * v[3]);
                        if (bj == 0) s0 += q; else s1 += q; }
                s0 += __shfl_xor(s0, 16); s0 += __shfl_xor(s0, 32); s1 += __shfl_xor(s1, 16); s1 += __shfl_xor(s1, 32);
                if (u.pn == 0) { if (fq == 0) PARTD[(size_t)row * 16 + wc] = s0 + s1; }
                else if (u.pn == 1) { if (fq == 0) { PARTD[(size_t)row * 16 + 4 + wc] = s0; PARTD[(size_t)row * 16 + 8 + wc] = s1; } }
                else if (rope) {
                    const int i = ri; const f32x4 cs = csv[m], sn = snv[m];
                    const f32x4 x1 = vv[0][0], x2 = vv[0][1]; const f32x4 y1 = x1 * cs - x2 * sn, y2 = x2 * cs + x1 * sn;
                    u32x2 w1 = {cvtpk(y1[0], y1[1]), cvtpk(y1[2], y1[3])}, w2 = {cvtpk(y2[0], y2[1]), cvtpk(y2[2], y2[3])};
                    *(u32x2*)(KR + (size_t)row * 64 + i) = w1; *(u32x2*)(KR + (size_t)row * 64 + 32 + i) = w2; } } }
    }
};
struct EpiBf16 {
    static constexpr bool PERM = true;
    bf16_t* O; int ldc; const float* PART; int s0, nq4; float invn;
    typedef int State;
    __device__ __forceinline__ void operator()(const f32x4 (&acc)[2][2][4][2], const Unit& u, int wr, int wc, int fr, int fq, State&) const {
        const int row0 = u.pm * BM + wr * 64 + fr, col0 = u.pn * BM + wc * 32 + 8 * fq;
        float rs[2][4]; rows_rstd(rs, PART, row0, s0, nq4, invn, fq);
#pragma unroll
        for (int ai = 0; ai < 2; ++ai)
#pragma unroll
            for (int m = 0; m < 4; ++m) { const int row = row0 + ai * HALF + m * 16; const float rstd = rs[ai][m];
                bf16_t* rowp = O + (size_t)row * ldc + col0;
#pragma unroll
                for (int bj = 0; bj < 2; ++bj) { const f32x4 v0 = acc[ai][bj][m][0] * rstd, v1 = acc[ai][bj][m][1] * rstd;
                    u32x4 w; w.x = cvtpk(v0[0], v0[1]); w.y = cvtpk(v0[2], v0[3]); w.z = cvtpk(v1[0], v1[1]); w.w = cvtpk(v1[2], v1[3]);
                    *(u32x4*)(rowp + bj * HALF) = w; } }
    }
};
__device__ __forceinline__ f32x4 silu_mul4(f32x4 g, f32x4 u) {
    const f32x4 t = g * (-1.4426950408889634f); f32x4 e;
#pragma unroll
    for (int i = 0; i < 4; ++i) e[i] = __builtin_amdgcn_exp2f(t[i]);
    const f32x4 d = e + 1.0f; f32x4 r;
#pragma unroll
    for (int i = 0; i < 4; ++i) r[i] = __builtin_amdgcn_rcpf(d[i]);
    return (g * u) * r;
}
struct EpiSwiglu {
    static constexpr bool PERM = true;
    bf16_t* O; int ldc; const float* PARTX; LAS float* rc;
    typedef int State;
    __device__ __forceinline__ void operator()(const f32x4 (&acc)[2][2][4][2], const Unit& u, int wr, int wc, int fr, int fq, State& st) const {
        const int row0 = u.pm * BM + wr * 64 + fr, col0 = u.pn * HALF + wc * 32 + 8 * fq;
        float rs[2][4];
        if (st != u.pm) { rows_rstd(rs, PARTX, row0, 0, 4, 1.0f / 1024.0f, fq); st = u.pm;
#pragma unroll
            for (int ai = 0; ai < 2; ++ai)
#pragma unroll
                for (int m = 0; m < 4; ++m) rc[wr * 64 + ai * HALF + m * 16 + fr] = rs[ai][m]; }
        else {
#pragma unroll
            for (int ai = 0; ai < 2; ++ai)
#pragma unroll
                for (int m = 0; m < 4; ++m) rs[ai][m] = rc[wr * 64 + ai * HALF + m * 16 + fr]; }
#pragma unroll
        for (int ai = 0; ai < 2; ++ai)
#pragma unroll
            for (int m = 0; m < 4; ++m) { const int row = row0 + ai * HALF + m * 16; const float rstd = rs[ai][m];
                bf16_t* rowp = O + (size_t)row * ldc + col0;
                const f32x4 a0 = silu_mul4(acc[ai][0][m][0] * rstd, acc[ai][1][m][0] * rstd), a1 = silu_mul4(acc[ai][0][m][1] * rstd, acc[ai][1][m][1] * rstd);
                u32x4 w; w.x = cvtpk(a0[0], a0[1]); w.y = cvtpk(a0[2], a0[3]); w.z = cvtpk(a1[0], a1[1]); w.w = cvtpk(a1[2], a1[3]);
                *(u32x4*)rowp = w; }
    }
};

template <class Epi>
__device__ __forceinline__ void gemm_phase(LAS unsigned char* lds, const Gemm g, const StaticOrder& S, const Epi& E) {
    const int tid = opq_tid(), wid = __builtin_amdgcn_readfirstlane(tid >> 6), lane = tid & 63, wr = wid >> 2, wc = wid & 3, fr = lane & 15, fq = lane >> 4;
    const int K = g.K, nt = K / BK;
    unsigned voffA[2], voffB[2];
#pragma unroll
    for (int i = 0; i < 2; ++i) { int R, C; stage_rc(tid * 16 + i * 8192, R, C); const int Rb = Epi::PERM ? ((R & ~31) + perm32(R & 31)) : R;
        voffA[i] = (unsigned)(R * g.lda + C) * 2u; voffB[i] = (unsigned)(Rb * g.ldb + C) * 2u; }
    const size_t kstep = (size_t)(BK * 2);
    const size_t hstepA = (size_t)HALF * g.lda * 2, hstepB = (size_t)HALF * g.ldb * 2;
    const size_t tstepA = 2 * hstepA, tstepB = 2 * hstepB;
    const size_t pnA = (size_t)g.a_pn_off * 2;
    const unsigned ldsw = (unsigned)wid * 1024u;
    const int aoff = lds_byte(wr * 64 + fr, fq * 8), boff = lds_byte(wc * 32 + fr, fq * 8);
#define PG8_SA(b, h) (((b) * 2 + (h)) * HTB)
#define PG8_SB(b, h) ((4 + (b) * 2 + (h)) * HTB)
#define PG8_STAGE(bufoff, gbase, voff) do { _Pragma("unroll") for (int _i = 0; _i < 2; ++_i) \
        __builtin_amdgcn_global_load_lds((const unsigned*)((const char*)(gbase) + (voff)[_i]), (LAS unsigned*)(lds + (bufoff) + ldsw + _i * 8192), 16, 0, 0); } while (0)
#define PG8_LDA(dst, b, h) do { _Pragma("unroll") for (int m = 0; m < 4; ++m) _Pragma("unroll") for (int k = 0; k < 2; ++k) dst[m][k] = *(const LAS bf16x8*)(lds + PG8_SA(b, h) + aoff + m * 2048 + k * 1024); } while (0)
#define PG8_LDB(dst, b, h) do { _Pragma("unroll") for (int n = 0; n < 2; ++n) _Pragma("unroll") for (int k = 0; k < 2; ++k) dst[n][k] = *(const LAS bf16x8*)(lds + PG8_SB(b, h) + boff + n * 2048 + k * 1024); } while (0)
#define PG8_MMA(ai, bj, At, Bt) do { __builtin_amdgcn_s_setprio(1); _Pragma("unroll") for (int m = 0; m < 4; ++m) _Pragma("unroll") for (int n = 0; n < 2; ++n) _Pragma("unroll") for (int k = 0; k < 2; ++k) \
        acc[ai][bj][m][n] = __builtin_amdgcn_mfma_f32_16x16x32_bf16(Bt[n][k], At[m][k], acc[ai][bj][m][n], 0, 0, 0); __builtin_amdgcn_s_setprio(0); } while (0)
#define PG8_WAIT_V(n) asm volatile("s_waitcnt vmcnt(" #n ")" ::: "memory")
#define PG8_WAIT_L(n) asm volatile("s_waitcnt lgkmcnt(" #n ")" ::: "memory")
#define PG8_BAR __builtin_amdgcn_s_barrier()
#define PG8_SCHED __builtin_amdgcn_sched_barrier(0)
    Unit cur, nxt; int ui = 0;
    if (!S.next(0, cur)) return;
    typename Epi::State est; *(int*)&est = -1;
    f32x4 acc[2][2][4][2];
#pragma unroll
    for (int a = 0; a < 2; ++a)
#pragma unroll
        for (int b = 0; b < 2; ++b)
#pragma unroll
            for (int m = 0; m < 4; ++m)
#pragma unroll
                for (int n = 0; n < 2; ++n) acc[a][b][m][n] = (f32x4){0.f, 0.f, 0.f, 0.f};
    bf16x8 At[4][2], B0[2][2], B1[2][2];
    const char* cA = (const char*)g.A + (size_t)cur.pm * tstepA + (size_t)cur.pn * pnA; const char* cB = (const char*)g.Bt + (size_t)cur.pn * tstepB;
    PG8_STAGE(PG8_SB(0, 0), cB, voffB); PG8_STAGE(PG8_SA(0, 0), cA, voffA); PG8_STAGE(PG8_SB(0, 1), cB + hstepB, voffB); PG8_STAGE(PG8_SA(0, 1), cA + hstepA, voffA);
    if (wr == 1) PG8_BAR;
    PG8_WAIT_V(4); PG8_BAR;
    PG8_STAGE(PG8_SB(1, 0), cB + kstep, voffB); PG8_STAGE(PG8_SA(1, 0), cA + kstep, voffA); PG8_STAGE(PG8_SB(1, 1), cB + hstepB + kstep, voffB);
    PG8_WAIT_V(6); PG8_BAR;
    for (;;) {
        const bool has_next = S.next(ui + 1, nxt);
        const char* nA = has_next ? (const char*)g.A + (size_t)nxt.pm * tstepA + (size_t)nxt.pn * pnA : cA; const char* nB = has_next ? (const char*)g.Bt + (size_t)nxt.pn * tstepB : cB;
        for (int t = 0; t < nt; t += 2) {
            const bool last = (t == nt - 2);
            const char* a1 = cA + (size_t)(t + 1) * kstep;
            const char* a2 = last ? nA : cA + (size_t)(t + 2) * kstep; const char* b2 = last ? nB : cB + (size_t)(t + 2) * kstep;
            const char* a3 = a2 + kstep; const char* b3 = b2 + kstep;
            PG8_LDB(B0, 0, 0); PG8_SCHED; PG8_LDA(At, 0, 0); PG8_STAGE(PG8_SA(1, 1), a1 + hstepA, voffA);
            PG8_WAIT_L(8); PG8_BAR; PG8_WAIT_L(0); PG8_MMA(0, 0, At, B0); PG8_BAR; PG8_SCHED;
            PG8_LDB(B1, 0, 1); PG8_STAGE(PG8_SB(0, 0), b2, voffB);
            PG8_BAR; PG8_WAIT_L(0); PG8_MMA(0, 1, At, B1); PG8_BAR;
            PG8_LDA(At, 0, 1); PG8_STAGE(PG8_SA(0, 0), a2, voffA);
            PG8_BAR; PG8_WAIT_L(0); PG8_MMA(1, 0, At, B0); PG8_BAR; PG8_SCHED;
            PG8_STAGE(PG8_SB(0, 1), b2 + hstepB, voffB);
            PG8_WAIT_V(6); PG8_BAR; PG8_MMA(1, 1, At, B1); PG8_BAR;
            PG8_LDB(B0, 1, 0); PG8_SCHED; PG8_LDA(At, 1, 0); PG8_STAGE(PG8_SA(0, 1), a2 + hstepA, voffA);
            PG8_WAIT_L(8); PG8_BAR; PG8_WAIT_L(0); PG8_MMA(0, 0, At, B0); PG8_BAR; PG8_SCHED;
            PG8_LDB(B1, 1, 1); PG8_STAGE(PG8_SB(1, 0), b3, voffB);
            PG8_BAR; PG8_WAIT_L(0); PG8_MMA(0, 1, At, B1); PG8_BAR;
            PG8_LDA(At, 1, 1); PG8_STAGE(PG8_SA(1, 0), a3, voffA);
            PG8_BAR; PG8_WAIT_L(0); PG8_MMA(1, 0, At, B0); PG8_BAR; PG8_SCHED;
            PG8_STAGE(PG8_SB(1, 1), b3 + hstepB, voffB);
            PG8_WAIT_V(6); PG8_BAR; PG8_MMA(1, 1, At, B1); PG8_BAR;
        }
        E(acc, cur, wr, wc, fr, fq, est);
        if (!has_next) break;
#pragma unroll
        for (int a = 0; a < 2; ++a)
#pragma unroll
            for (int b = 0; b < 2; ++b)
#pragma unroll
                for (int m = 0; m < 4; ++m)
#pragma unroll
                    for (int n = 0; n < 2; ++n) acc[a][b][m][n] = (f32x4){0.f, 0.f, 0.f, 0.f};
        cur = nxt; cA = nA; cB = nB; ++ui;
    }
    PG8_WAIT_V(0);
    if (wr == 0) PG8_BAR;
    PG8_BAR;
#undef PG8_SA
#undef PG8_SB
#undef PG8_STAGE
#undef PG8_LDA
#undef PG8_LDB
#undef PG8_MMA
#undef PG8_WAIT_V
#undef PG8_WAIT_L
#undef PG8_BAR
#undef PG8_SCHED
}
}

namespace at {
constexpr float SCALE = 0.07216878364870322f;
constexpr float THR = 8.f;
constexpr int SHM_V = 16384, SHM_K = 16384, SHM_KR = 8192;
#define KSWZ(row, colB) ((row) * 256 + ((colB) ^ (((row) & 7) << 4)))
#define SBAR() __builtin_amdgcn_sched_barrier(0)
__device__ __forceinline__ int v_st(int k, int c) { const int kk = (k & ~0xC) | ((k & 4) << 1) | ((k & 8) >> 1); return ((kk >> 3) * 4 + (c >> 5)) * 512 + ((kk & 7) * 32 + (c & 31)) * 2; }
__device__ __forceinline__ int v_rd_base(int lane) { return ((lane & 3) << 3) | (((lane >> 2) & 3) << 6) | (((lane >> 4) & 1) << 5) | (((lane >> 5) & 1) << 8); }
constexpr int v_rd_off(int d0, int ks, int half) { return d0 * 512 + ks * 4096 + half * 2048; }
__device__ __forceinline__ int crow(int r, int hi) { return (r & 3) + 8 * (r >> 2) + 4 * hi; }
__device__ __forceinline__ void mask_tile(f32x16& p0, f32x16& p1, int dq, unsigned W) {
    const float NEG = -__builtin_inff();
#pragma unroll
    for (int r = 0; r < 16; ++r) {
        const int c = (r & 3) + 8 * (r >> 2);
        if ((unsigned)(dq - c) >= W) p0[r] = NEG;
        if ((unsigned)(dq - c - 32) >= W) p1[r] = NEG;
    }
}
__device__ __forceinline__ void partialSM(f32x16& p0, f32x16& p1, float& m_reg, float& mn, float& alpha) {
    float pmax = p0[0];
#pragma unroll
    for (int r = 1; r < 16; ++r) pmax = fmaxf(pmax, p0[r]);
#pragma unroll
    for (int r = 0; r < 16; ++r) pmax = fmaxf(pmax, p1[r]);
    { auto rr = __builtin_amdgcn_permlane32_swap(__float_as_uint(pmax), __float_as_uint(pmax), false, false);
      pmax = fmaxf(__uint_as_float(rr[0]), __uint_as_float(rr[1])); }
    constexpr float C2 = 1.4426950408889634f * SCALE;
    if (__builtin_expect(__all((pmax - m_reg) * SCALE <= THR), 1)) { mn = m_reg; alpha = 1.f; }
    else { mn = fmaxf(m_reg, pmax); alpha = __builtin_amdgcn_exp2f((m_reg - mn) * C2); m_reg = mn; }
    const float mnL = -mn * C2;
#pragma unroll
    for (int r = 0; r < 16; ++r) p0[r] = fmaf(p0[r], C2, mnL);
#pragma unroll
    for (int r = 0; r < 16; ++r) p1[r] = fmaf(p1[r], C2, mnL);
#pragma unroll
    for (int r = 0; r < 16; ++r) p0[r] = __builtin_amdgcn_exp2f(p0[r]);
}
__device__ __forceinline__ void finishSM(f32x16& p0, f32x16& p1, float alpha, float& l_reg, bf16x8& pa0, bf16x8& pa1, bf16x8& pa2, bf16x8& pa3) {
#pragma unroll
    for (int r = 0; r < 16; ++r) p1[r] = __builtin_amdgcn_exp2f(p1[r]);
    float ps = 0;
#pragma unroll
    for (int r = 0; r < 16; ++r) ps += p0[r];
#pragma unroll
    for (int r = 0; r < 16; ++r) ps += p1[r];
    { auto rr = __builtin_amdgcn_permlane32_swap(__float_as_uint(ps), __float_as_uint(ps), false, false);
      ps = __uint_as_float(rr[0]) + __uint_as_float(rr[1]); }
    l_reg = l_reg * alpha + ps;
#define PK4(P, B_, OUT) do { unsigned a0 = cvtpk(P[B_+0], P[B_+1]), a1 = cvtpk(P[B_+2], P[B_+3]);                          \
        unsigned b0 = cvtpk(P[B_+4], P[B_+5]), b1 = cvtpk(P[B_+6], P[B_+7]);                                             \
        auto r0 = __builtin_amdgcn_permlane32_swap(a0, b0, false, false); auto r1 = __builtin_amdgcn_permlane32_swap(a1, b1, false, false); \
        u32x4 w = {r0[0], r1[0], r0[1], r1[1]}; OUT = *reinterpret_cast<bf16x8*>(&w); } while (0)
    PK4(p0, 0, pa0); PK4(p0, 8, pa1); PK4(p1, 0, pa2); PK4(p1, 8, pa3);
#undef PK4
}
__device__ __forceinline__ void qkt(f32x16& p0, f32x16& p1, const char* K_lds, const char* KR_lds, const char* QR_l, int r32, int hi, const bf16x8* qr) {
    p0 = f32x16{}; p1 = f32x16{};
    const char* kb[4];
#pragma unroll
    for (int dd = 0; dd < 4; ++dd) kb[dd] = K_lds + KSWZ(r32, (dd * 16 + hi * 8) * 2);
#pragma unroll
    for (int d0 = 0; d0 < 8; ++d0) { const char* a = kb[d0 & 3] + (d0 >> 2) * 128;
        bf16x8 b0 = *reinterpret_cast<const bf16x8*>(a);
        bf16x8 b1 = *reinterpret_cast<const bf16x8*>(a + 32 * 256);
        p0 = __builtin_amdgcn_mfma_f32_32x32x16_bf16(b0, qr[d0], p0, 0, 0, 0);
        p1 = __builtin_amdgcn_mfma_f32_32x32x16_bf16(b1, qr[d0], p1, 0, 0, 0); }
#pragma unroll
    for (int d1 = 0; d1 < 4; ++d1) { const char* a = KR_lds + r32 * 128 + (((d1 * 16 + hi * 8) * 2) ^ ((r32 & 7) << 4));
        bf16x8 b0 = *reinterpret_cast<const bf16x8*>(a);
        bf16x8 b1 = *reinterpret_cast<const bf16x8*>(a + 32 * 128);
        const bf16x8 qv = *reinterpret_cast<const bf16x8*>(QR_l + d1 * 1024);
        p0 = __builtin_amdgcn_mfma_f32_32x32x16_bf16(b0, qv, p0, 0, 0, 0);
        p1 = __builtin_amdgcn_mfma_f32_32x32x16_bf16(b1, qv, p1, 0, 0, 0); }
}
__device__ __forceinline__ void pv_tile(f32x16* o, int vb0, bf16x8 pa0, bf16x8 pa1, bf16x8 pa2, bf16x8 pa3) {
#define TRRD(dst, off) asm volatile("ds_read_b64_tr_b16 %0, %1 offset:%2" : "=&v"(dst) : "v"(vb0), "i"(off) : "memory")
#define PV_D0(d0) do { s16x4 l0, l1, l2, l3, h0, h1, h2, h3; constexpr int b_ = v_rd_off(d0, 0, 0); \
        TRRD(l0, b_); TRRD(h0, b_ + 2048); TRRD(l1, b_ + 4096); TRRD(h1, b_ + 6144); TRRD(l2, b_ + 8192); TRRD(h2, b_ + 10240); TRRD(l3, b_ + 12288); TRRD(h3, b_ + 14336); \
        asm volatile("s_waitcnt lgkmcnt(0)" ::: "memory"); SBAR();   \
        o[d0] = __builtin_amdgcn_mfma_f32_32x32x16_bf16(pa0, (bf16x8){l0[0], l0[1], l0[2], l0[3], h0[0], h0[1], h0[2], h0[3]}, o[d0], 0, 0, 0);   \
        o[d0] = __builtin_amdgcn_mfma_f32_32x32x16_bf16(pa1, (bf16x8){l1[0], l1[1], l1[2], l1[3], h1[0], h1[1], h1[2], h1[3]}, o[d0], 0, 0, 0);   \
        o[d0] = __builtin_amdgcn_mfma_f32_32x32x16_bf16(pa2, (bf16x8){l2[0], l2[1], l2[2], l2[3], h2[0], h2[1], h2[2], h2[3]}, o[d0], 0, 0, 0);   \
        o[d0] = __builtin_amdgcn_mfma_f32_32x32x16_bf16(pa3, (bf16x8){l3[0], l3[1], l3[2], l3[3], h3[0], h3[1], h3[2], h3[3]}, o[d0], 0, 0, 0); } while (0)
    PV_D0(0); PV_D0(1); PV_D0(2); PV_D0(3);
#undef PV_D0
#undef TRRD
}

__device__ __forceinline__ void attn_qblock(const bf16_t* __restrict__ Q, const bf16_t* __restrict__ KV, const bf16_t* __restrict__ KR,
                                            const float* __restrict__ ctab, const float* __restrict__ stab, bf16_t* __restrict__ O,
                                            int b, int h, int qb, char* lds) {
    const int tid = opq_tid(), wid = __builtin_amdgcn_readfirstlane(tid >> 6), lane = tid & 63, r32 = lane & 31, hi = lane >> 5;
    const int P0 = qb * 256, NT = P0 / 64 + 4, tok0 = b * SEQ;
    constexpr int KBUF = SHM_K + SHM_KR, VOFF = 2 * KBUF, WOFF = VOFF + 3 * SHM_V;
    float* wsl = (float*)(lds + WOFF) + wid * 64; float* li_l = wsl; float* al_l = wsl + 32;
    char* QR_l = lds + WOFF + 2048 + wid * 4096 + lane * 16;
    const int qlo = P0 + wid * 32, qm = qlo + r32 - 4 * hi;
    const int qtok = tok0 + qlo + r32;
    bf16x8 qr[8];
    { bf16x8 qx[4];
      const bf16_t* qp = Q + (size_t)qtok * 1536 + h * 192 + hi * 8;
#pragma unroll
      for (int d0 = 0; d0 < 8; ++d0) qr[d0] = *(const bf16x8*)(qp + d0 * 16);
#pragma unroll
      for (int d0 = 0; d0 < 4; ++d0) qx[d0] = *(const bf16x8*)(qp + 128 + d0 * 16);
#pragma unroll
      for (int dd = 0; dd < 2; ++dd) {
          const int i0 = dd * 16 + hi * 8;
          const f32x4 c0 = *(const f32x4*)(ctab + (size_t)qtok * 32 + i0), c1 = *(const f32x4*)(ctab + (size_t)qtok * 32 + i0 + 4);
          const f32x4 s0 = *(const f32x4*)(stab + (size_t)qtok * 32 + i0), s1 = *(const f32x4*)(stab + (size_t)qtok * 32 + i0 + 4);
          f32x4 a0, a1, b0, b1;
#pragma unroll
          for (int e = 0; e < 4; ++e) {
              const float x1 = bf2f(qx[dd][e]), x2 = bf2f(qx[2 + dd][e]);
              a0[e] = x1 * c0[e] - x2 * s0[e]; b0[e] = x2 * c0[e] + x1 * s0[e];
              const float y1 = bf2f(qx[dd][4 + e]), y2 = bf2f(qx[2 + dd][4 + e]);
              a1[e] = y1 * c1[e] - y2 * s1[e]; b1[e] = y2 * c1[e] + y1 * s1[e];
          }
          *(bf16x8*)(QR_l + dd * 1024) = pack8(a0, a1); *(bf16x8*)(QR_l + (2 + dd) * 1024) = pack8(b0, b1);
      } }
    const int sr = tid >> 4, sc = (tid & 15) * 8, vst0 = v_st(sr, sc), vst1 = v_st(32 + sr, sc), kws = KSWZ(sr, sc * 2);
    const int rr = tid >> 3, rc = (tid & 7) * 8, krws = rr * 128 + ((rc * 2) ^ ((rr & 7) << 4));
    const int vbase = (int)(uintptr_t)lds + VOFF + v_rd_base(lane);
    const bf16_t* kvp = KV + (size_t)(tok0 + sr) * 2048 + h * 256 + sc;
    const bf16_t* krp = KR + (size_t)(tok0 + rr) * 64 + rc;
    bf16x8 st_k0, st_k1, st_v0, st_v1, st_kr;
#define LOADT(t) do { const bf16_t* p_ = kvp + (size_t)(t) * 64 * 2048; st_k0 = *(const bf16x8*)p_; st_v0 = *(const bf16x8*)(p_ + 128); \
        st_k1 = *(const bf16x8*)(p_ + 32 * 2048); st_v1 = *(const bf16x8*)(p_ + 32 * 2048 + 128); st_kr = *(const bf16x8*)(krp + (size_t)(t) * 64 * 64); } while (0)
#define WRITET(ko, vo) do { char* k_ = lds + (ko); char* v_ = lds + VOFF + (vo); *(bf16x8*)(k_ + kws) = st_k0; *(bf16x8*)(k_ + kws + 32 * 256) = st_k1; \
        *(bf16x8*)(v_ + vst0) = st_v0; *(bf16x8*)(v_ + vst1) = st_v1; *(bf16x8*)(k_ + SHM_K + krws) = st_kr; } while (0)
#define RESC(a) do { if (__any((a) < 1.f)) { if (hi == 0) al_l[r32] = (a); asm volatile("s_waitcnt lgkmcnt(0)" ::: "memory"); \
        _Pragma("unroll") for (int d_ = 0; d_ < 4; ++d_) _Pragma("unroll") for (int r = 0; r < 16; ++r) o[d_][r] *= al_l[crow(r, hi)]; } } while (0)
    float m_reg = -1e30f, l_reg = 0.f; f32x16 o[4] = {};
    f32x16 pA0 = f32x16{}, pA1 = f32x16{}, pB0 = f32x16{}, pB1 = f32x16{}; float mnA = 0.f, alA = 1.f, mnB = 0.f, alB = 1.f;
    bf16x8 pa0 = bf16x8{}, pa1 = bf16x8{}, pa2 = bf16x8{}, pa3 = bf16x8{};
    int vcur = 0, vprev = 2 * SHM_V;
#define STEP(PX0, PX1, mnX, alX, PY0, PY1, alY, t) do { \
        const int kcur_ = ((t) & 1) * KBUF, vnext_ = vcur == 2 * SHM_V ? 0 : vcur + SHM_V; \
        if ((t) + 1 < NT) { WRITET(KBUF - kcur_, vnext_); if ((t) + 2 < NT) LOADT((t) + 2); } \
        const int kb_ = (t) * 64; const bool actX_ = kb_ <= qlo + 31, actY_ = (t) > 0 && kb_ - 64 <= qlo + 31; \
        SBAR(); if (actX_) qkt(PX0, PX1, lds + kcur_, lds + kcur_ + SHM_K, QR_l, r32, hi, qr); \
        if (actY_) { finishSM(PY0, PY1, alY, l_reg, pa0, pa1, pa2, pa3); SBAR(); pv_tile(o, vbase + vprev, pa0, pa1, pa2, pa3); } \
        if (actX_) { if (kb_ + 63 > qlo) mask_tile(PX0, PX1, qm - kb_, 0x40000000u); partialSM(PX0, PX1, m_reg, mnX, alX); RESC(alX); } \
        vprev = vcur; vcur = vnext_; \
        __syncthreads(); } while (0)
    LOADT(0);
    __syncthreads();
    WRITET(0, 0);
    LOADT(1);
    __syncthreads();
    STEP(pA0, pA1, mnA, alA, pB0, pB1, alB, 0);
    for (int t = 1; t + 1 < NT; t += 2) {
        STEP(pB0, pB1, mnB, alB, pA0, pA1, alA, t);
        STEP(pA0, pA1, mnA, alA, pB0, pB1, alB, t + 1);
    }
    STEP(pB0, pB1, mnB, alB, pA0, pA1, alA, NT - 1);
    if ((NT - 1) * 64 <= qlo + 31) { finishSM(pB0, pB1, alB, l_reg, pa0, pa1, pa2, pa3); SBAR(); pv_tile(o, vbase + vprev, pa0, pa1, pa2, pa3); }
#undef STEP
#undef RESC
#undef WRITET
#undef LOADT
    if (hi == 0) li_l[r32] = l_reg; asm volatile("s_waitcnt lgkmcnt(0)" ::: "memory");
    bf16_t* Ow = O + (size_t)(tok0 + qlo) * 1024 + h * 128;
#pragma unroll
    for (int r = 0; r < 16; ++r) { const int orow = crow(r, hi); const float rli = __builtin_amdgcn_rcpf(li_l[orow]);
#pragma unroll
        for (int d0 = 0; d0 < 4; ++d0) { const float v = o[d0][r] * rli; const float vn = __shfl_xor(v, 1);
            if ((r32 & 1) == 0) *(unsigned*)(Ow + (size_t)orow * 1024 + d0 * 32 + r32) = cvtpk(v, vn); } }
}
__device__ __forceinline__ void attn_phase(const bf16_t* Q, const bf16_t* KV, const bf16_t* KR, const float* ctab, const float* stab, bf16_t* O, char* lds) {
    for (int L = blockIdx.x; L < 512; L += gridDim.x) {
        const int xcd = L & 7, k = L >> 3, bh = xcd * 8 + (k >> 3), x = k & 7;
        attn_qblock(Q, KV, KR, ctab, stab, O, bh >> 3, bh & 7, 15 - x, lds);
        attn_qblock(Q, KV, KR, ctab, stab, O, bh >> 3, bh & 7, x, lds);
    }
    __syncthreads();
}
}

struct CvtTile { const float* src; bf16_t* dst; const float* scale; const float* kscale; int ldsrc, lddst, kind, k0, ng; };
__device__ __forceinline__ CvtTile cvt_decode(const Params& p, int u, int tid) {
    unsigned char* ws = p.ws;
    constexpr int C_POOL = 8 * 8, C_MD = 2 * 72, C_UQ = 2 * 72, C_UKV = 2 * 32, C_WO = 2 * 128, C_G = 4 * 352;
    CvtTile t; t.scale = nullptr; t.kscale = nullptr; t.kind = 0;
    int r = u, mtx, ntl;
    if (r < C_POOL) { mtx = r / 8; r %= 8; t.src = p.pool_w + (size_t)mtx * 65536; t.ldsrc = 256; t.dst = (bf16_t*)(ws + OFF_WPOOL) + (size_t)mtx * 65536; t.lddst = 256; ntl = 4; t.scale = p.pool_scale + mtx * 256; }
    else if ((r -= C_POOL) < C_MD) { mtx = r / 72; r %= 72; t.src = p.w_down + (size_t)mtx * 1024 * 576; t.ldsrc = 576; t.dst = (bf16_t*)(ws + OFF_WMD) + (size_t)mtx * 768 * 1024; t.lddst = 1024; ntl = 9; t.kind = 3; t.kscale = p.norm_mix + (2 * mtx + 1) * 1024; }
    else if ((r -= C_MD) < C_UQ) { mtx = r / 72; r %= 72; t.src = p.w_uq + (size_t)mtx * 384 * 1536; t.ldsrc = 1536; t.dst = (bf16_t*)(ws + OFF_WUQ) + (size_t)mtx * 1536 * 384; t.lddst = 384; ntl = 24; t.kscale = p.q_norm + mtx * 384; }
    else if ((r -= C_UQ) < C_UKV) { mtx = r / 32; r %= 32; t.src = p.w_ukv + (size_t)mtx * 128 * 2048; t.ldsrc = 2048; t.dst = (bf16_t*)(ws + OFF_WUKV) + (size_t)mtx * 2048 * 128; t.lddst = 128; ntl = 32; t.kscale = p.kv_norm + mtx * 128; }
    else if ((r -= C_UKV) < C_WO) { mtx = r / 128; r %= 128; t.src = p.w_o + (size_t)mtx * 1024 * 1024; t.ldsrc = 1024; t.dst = (bf16_t*)(ws + OFF_WO) + (size_t)mtx * 1024 * 1024; t.lddst = 1024; ntl = 16; }
    else if ((r -= C_WO) < C_G) { mtx = r / 352; r %= 352; t.src = p.w_gate + (size_t)mtx * 1024 * FF; t.ldsrc = FF; t.dst = (bf16_t*)(ws + OFF_WGU) + (size_t)mtx * 5632 * 1024; t.lddst = 1024; ntl = 44; t.kind = 1; t.kscale = p.norm_ffn + mtx * 1024; }
    else if ((r -= C_G) < C_G) { mtx = r / 352; r %= 352; t.src = p.w_up + (size_t)mtx * 1024 * FF; t.ldsrc = FF; t.dst = (bf16_t*)(ws + OFF_WGU) + (size_t)mtx * 5632 * 1024; t.lddst = 1024; ntl = 44; t.kind = 2; t.kscale = p.norm_ffn + mtx * 1024; }
    else { r -= C_G; mtx = r / 352; r %= 352; t.src = p.w_dn + (size_t)mtx * FF * 1024; t.ldsrc = 1024; t.dst = (bf16_t*)(ws + OFF_WDN) + (size_t)mtx * 1024 * FF; t.lddst = FF; ntl = 16; }
    t.k0 = (r / ntl) * 128 + (tid >> 6) * 16; t.ng = (r % ntl) * 64 + (tid & 63);
    return t;
}
__device__ __forceinline__ void cvt_finish(const CvtTile& t, float (&v)[16]) {
    if (t.scale) { const float sc = t.scale[t.ng];
#pragma unroll
        for (int i = 0; i < 16; ++i) v[i] *= sc; }
    if (t.kscale) {
#pragma unroll
        for (int q = 0; q < 4; ++q) { const f32x4 kq = *(const f32x4*)(t.kscale + t.k0 + 4 * q);
#pragma unroll
            for (int i = 0; i < 4; ++i) v[4 * q + i] *= kq[i]; } }
    int drow = t.ng;
    if (t.kind == 1 || t.kind == 2) drow = (t.ng >> 7) * 256 + (t.ng & 127) + (t.kind == 2 ? 128 : 0);
    else if (t.kind == 3 && t.ng >= 512) { const int q = t.ng - 512, half = q >> 5, i2 = q & 31; drow = 512 + (i2 >> 4) * 32 + half * 16 + (i2 & 15); }
    u32x4 w0 = {cvtpk(v[0], v[1]), cvtpk(v[2], v[3]), cvtpk(v[4], v[5]), cvtpk(v[6], v[7])}, w1 = {cvtpk(v[8], v[9]), cvtpk(v[10], v[11]), cvtpk(v[12], v[13]), cvtpk(v[14], v[15])};
    *(u32x4*)(t.dst + (size_t)drow * t.lddst + t.k0) = w0; *(u32x4*)(t.dst + (size_t)drow * t.lddst + t.k0 + 8) = w1;
}
__device__ __forceinline__ void cvt_phase(const Params& p, unsigned char* smem) {
    const int tid = opq_tid();
    unsigned char* ws = p.ws;
    constexpr int TOTAL = 8 * 8 + 2 * 72 + 2 * 72 + 2 * 32 + 2 * 128 + 3 * 4 * 352;
    for (int u = blockIdx.x; u < TOTAL; u += 2 * gridDim.x) {
        const int u2 = u + gridDim.x; const bool two = u2 < TOTAL;
        const CvtTile ta = cvt_decode(p, u, tid), tb = cvt_decode(p, two ? u2 : u, tid);
        float va[16], vb[16];
#pragma unroll
        for (int i = 0; i < 16; ++i) va[i] = ta.src[(size_t)(ta.k0 + i) * ta.ldsrc + ta.ng];
#pragma unroll
        for (int i = 0; i < 16; ++i) vb[i] = tb.src[(size_t)(tb.k0 + i) * tb.ldsrc + tb.ng];
        cvt_finish(ta, va);
        if (two) cvt_finish(tb, vb);
    }
    const int gt = blockIdx.x * 512 + tid, gn = gridDim.x * 512;
    unsigned zz = 0u; asm volatile("" : "+v"(zz)); const u32x4 z = {zz, zz, zz, zz};
    for (int i = gt; i < 2 * 192 * 128; i += gn) { const int l = i / (192 * 128), q = i % (192 * 128);
        *(u32x4*)((bf16_t*)(ws + OFF_WMD) + (size_t)l * 768 * 1024 + (size_t)576 * 1024 + (size_t)q * 8) = z; }
    float* ctab = (float*)(ws + OFF_CTAB); float* stab = (float*)(ws + OFF_STAB);
    for (int i = gt; i < T * 32; i += gn) { const int tok = i >> 5, j = i & 31;
        const float inv = 1.0f / exp2f((float)j * (13.287712379549449f / 32.0f));
        const float ang = (float)p.pos[tok] * inv;
        const double rev = (double)ang * 0.15915494309189535;
        const float fr = (float)(rev - rint(rev));
        ctab[i] = __builtin_amdgcn_cosf(fr); stab[i] = __builtin_amdgcn_sinf(fr); }
}

template <class TX>
__device__ __forceinline__ void norm_phase(const TX* x, const float* g, bf16_t* outb, float* outf) {
    const int tid = opq_tid(), lane = tid & 63, gw = blockIdx.x * 8 + (tid >> 6), nw = gridDim.x * 8;
    f32x4 gv[4];
#pragma unroll
    for (int i = 0; i < 4; ++i) gv[i] = *(const f32x4*)(g + (lane + 64 * i) * 4);
    int nw2 = nw; asm volatile("" : "+s"(nw2));
    for (int row = gw; row < T; row += 2 * nw2) {
        const int row2 = row + nw2 < T ? row + nw2 : row;
        const TX* xr = x + (size_t)row * 1024; const TX* xr2 = x + (size_t)row2 * 1024;
        f32x4 v[4], v2[4]; float ss = 0.f, ss2 = 0.f;
#pragma unroll
        for (int i = 0; i < 4; ++i) { v[i] = ld4(xr + (lane + 64 * i) * 4); v2[i] = ld4(xr2 + (lane + 64 * i) * 4); }
#pragma unroll
        for (int i = 0; i < 4; ++i) { ss += v[i][0] * v[i][0] + v[i][1] * v[i][1] + v[i][2] * v[i][2] + v[i][3] * v[i][3]; ss2 += v2[i][0] * v2[i][0] + v2[i][1] * v2[i][1] + v2[i][2] * v2[i][2] + v2[i][3] * v2[i][3]; }
        ss = wave_sum(ss); ss2 = wave_sum(ss2);
        const float rstd = rsqrtf(ss * (1.0f / 1024.0f) + EPS), rstd2 = rsqrtf(ss2 * (1.0f / 1024.0f) + EPS);
#pragma unroll
        for (int i = 0; i < 4; ++i) { const f32x4 y = v[i] * rstd * gv[i], y2 = v2[i] * rstd2 * gv[i];
            if (outb) { u32x2 w = {cvtpk(y[0], y[1]), cvtpk(y[2], y[3])}; *(u32x2*)(outb + (size_t)row * 1024 + (lane + 64 * i) * 4) = w;
                        u32x2 w2 = {cvtpk(y2[0], y2[1]), cvtpk(y2[2], y2[3])}; *(u32x2*)(outb + (size_t)row2 * 1024 + (lane + 64 * i) * 4) = w2; }
            else { *(f32x4*)(outf + (size_t)row * 1024 + (lane + 64 * i) * 4) = y; *(f32x4*)(outf + (size_t)row2 * 1024 + (lane + 64 * i) * 4) = y2; } }
    }
}

__device__ __forceinline__ void final_norm_phase(const bf16_t* __restrict__ x, const float* g, float* __restrict__ out) {
    const int tid = opq_tid(), lane = tid & 63; int gw = blockIdx.x * 8 + (tid >> 6), nw = gridDim.x * 8;
    asm volatile("" : "+s"(nw));
    f32x4 gv[4];
#pragma unroll
    for (int i = 0; i < 4; ++i) gv[i] = *(const f32x4*)(g + (i >> 1) * 512 + lane * 8 + (i & 1) * 4);
    for (int row = gw; row < T; row += 8 * nw) {
        u32x4 raw[8][2];
#pragma unroll
        for (int q = 0; q < 8; ++q) { const int rq = row + q * nw < T ? row + q * nw : row; const bf16_t* xr = x + (size_t)rq * 1024 + lane * 8;
            raw[q][0] = *(const u32x4*)xr; raw[q][1] = *(const u32x4*)(xr + 512); }
#pragma unroll
        for (int q = 0; q < 8; ++q) { const int rq = row + q * nw < T ? row + q * nw : row;
            f32x4 v[4]; float ss = 0.f;
#pragma unroll
            for (int i = 0; i < 4; ++i) { const unsigned w0 = raw[q][i >> 1][(i & 1) * 2], w1 = raw[q][i >> 1][(i & 1) * 2 + 1];
                v[i] = f32x4{__uint_as_float(w0 << 16), __uint_as_float(w0 & 0xffff0000u), __uint_as_float(w1 << 16), __uint_as_float(w1 & 0xffff0000u)};
                ss += (v[i][0] * v[i][0] + v[i][1] * v[i][1]) + (v[i][2] * v[i][2] + v[i][3] * v[i][3]); }
            ss = wave_sum(ss);
            const float rstd = rsqrtf(ss * (1.0f / 1024.0f) + EPS);
            float* orow = out + (size_t)rq * 1024 + lane * 8;
#pragma unroll
            for (int i = 0; i < 4; ++i) *(f32x4*)(orow + (i >> 1) * 512 + (i & 1) * 4) = v[i] * rstd * gv[i]; }
    }
}

template <int WIN, class TX>
__device__ __forceinline__ void pool_rows(const TX* xc, const float* rs, float g0, float g1, bf16_t* Pc, int s0) {
    float2 h[31 + WIN];
#pragma unroll
    for (int i = 0; i < 31 + WIN; ++i) { const int j = i - (WIN - 1);
        if (s0 + j >= 0) { const float2 xv = ld2(xc + (ptrdiff_t)j * 1024); const float r = rs[16 + j]; h[i] = make_float2(xv.x * r * g0, xv.y * r * g1); }
        else h[i] = make_float2(0.f, 0.f); }
    float S0 = 0.f, S1 = 0.f;
#pragma unroll
    for (int i = 0; i < WIN - 1; ++i) { S0 += h[i].x; S1 += h[i].y; }
#pragma unroll
    for (int k = 0; k < 32; ++k) { const int i = k + WIN - 1, s = s0 + k; S0 += h[i].x; S1 += h[i].y;
        const int na = s + 1 < WIN ? s + 1 : WIN; const float inv = 1.0f / (float)na;
        *(unsigned*)(Pc + (size_t)k * 1024) = cvtpk(S0 * inv - h[i].x, S1 * inv - h[i].y);
        S0 -= h[k].x; S1 -= h[k].y; }
}
template <class TX>
__device__ __forceinline__ void poolnorm_phase(const TX* x, const float* g, bf16_t* P, const float* part, unsigned char* smem) {
    float* rs = (float*)smem;
    const int tid = opq_tid(), wid = tid >> 6, lane = tid & 63;
    const int c = tid * 2;
    const float g0 = g[c], g1 = g[c + 1];
    for (int tile = blockIdx.x; tile < T / 32; tile += gridDim.x) {
        const int t0 = tile * 32, s0 = t0 & (SEQ - 1);
        if (part) {
            if (tid < 48 && s0 - 16 + tid >= 0) { const f32x4* pp = (const f32x4*)(part + (size_t)(t0 - 16 + tid) * 16); float ss = 0.f;
#pragma unroll
                for (int i = 0; i < 4; ++i) { const f32x4 v = pp[i]; ss += (v[0] + v[1]) + (v[2] + v[3]); }
                rs[tid] = rsqrtf(ss * (1.0f / 1024.0f) + EPS); }
        } else
        { float ssq[6];
#pragma unroll
          for (int k = 0; k < 6; ++k) { const int rr = wid * 6 + k, s = s0 - 16 + rr; float ss = 0.f;
              if (s >= 0) { const TX* xr = x + (size_t)(t0 - 16 + rr) * 1024;
#pragma unroll
                  for (int i = 0; i < 4; ++i) { const f32x4 v = ld4(xr + (lane + 64 * i) * 4); ss += v[0] * v[0] + v[1] * v[1] + v[2] * v[2] + v[3] * v[3]; } }
              ssq[k] = ss; }
#pragma unroll
          for (int k = 0; k < 6; ++k) { const float ss = wave_sum(ssq[k]); if (lane == 0) rs[wid * 6 + k] = rsqrtf(ss * (1.0f / 1024.0f) + EPS); } }
        __syncthreads();
        { const TX* xc = x + (size_t)t0 * 1024 + c; bf16_t* Pc = P + (size_t)t0 * 1024 + c;
          const int grp = __builtin_amdgcn_readfirstlane(wid >> 1);
          if (grp == 0) pool_rows<2, TX>(xc, rs, g0, g1, Pc, s0); else if (grp == 1) pool_rows<4, TX>(xc, rs, g0, g1, Pc, s0);
          else if (grp == 2) pool_rows<8, TX>(xc, rs, g0, g1, Pc, s0); else pool_rows<16, TX>(xc, rs, g0, g1, Pc, s0); }
        __syncthreads();
    }
}

#define XB_TMO      128
#define XB_XCNT(j)  (256  + 64 * (j))
#define XB_XSUB(j)  (1280 + 64 * (j))
#define XB_XGEN(j)  (2304 + 64 * (j))
#define XB_TOP      3328
#define XB_TOPGEN   3392
#define XCD_BAR_WORDS 3456
#define XB_SPIN_CAP (1u << 18)

__device__ __forceinline__ unsigned xb_ld(unsigned* p)              { return __hip_atomic_load(p, __ATOMIC_RELAXED, __HIP_MEMORY_SCOPE_AGENT); }
__device__ __forceinline__ unsigned xb_add(unsigned* p, unsigned v) { return __hip_atomic_fetch_add(p, v, __ATOMIC_RELAXED, __HIP_MEMORY_SCOPE_AGENT); }
__device__ __forceinline__ unsigned xb_xcc_id() { return (unsigned)__builtin_amdgcn_s_getreg((3 << 11) | 20) & 0xFu; }
#define XB_SPIN(cond, bar) do { unsigned _sp = 0; while (cond) { __builtin_amdgcn_s_sleep(1); \
    if ((++_sp & 255u) == 0u) { if (xb_ld(&(bar)[XB_TMO])) break; if (_sp > XB_SPIN_CAP) { atomicAdd(&(bar)[XB_TMO], 1u); break; } } } } while (0)

struct XcdBarrier {
    unsigned* bar; unsigned x;
    volatile LAS unsigned* st;
};

__device__ __forceinline__ XcdBarrier xcd_barrier_post(unsigned* bar, volatile LAS unsigned* st) {
    XcdBarrier b; b.bar = bar; b.x = xb_xcc_id(); b.st = st;
    if (threadIdx.x == 0) (void)xb_add(&bar[XB_XCNT(b.x)], 1u);
    return b;
}
__device__ __forceinline__ void xcd_barrier_complete(unsigned* bar, unsigned x, unsigned& nloc, unsigned& nx) {
    const unsigned G = gridDim.x * gridDim.y * gridDim.z;
    unsigned sum, cnt, mine, sp = 0u;
    for (;;) {
        sum = 0u; cnt = 0u; mine = 0u;
#pragma unroll
        for (unsigned j = 0; j < 16; ++j) { const unsigned c = xb_ld(&bar[XB_XCNT(j)]); sum += c; cnt += (c > 0u) ? 1u : 0u; mine = (j == x) ? c : mine; }
        if (sum == G) break;
        __builtin_amdgcn_s_sleep(1);
        if ((++sp & 255u) == 0u) { if (xb_ld(&bar[XB_TMO])) break; if (sp > XB_SPIN_CAP) { atomicAdd(&bar[XB_TMO], 1u); break; } }
    }
    nloc = mine > 0u ? mine : 1u; nx = cnt > 0u ? cnt : 1u;
}

__device__ __forceinline__ void xcd_barrier(const XcdBarrier& b) {
    asm volatile("s_waitcnt vmcnt(0)" ::: "memory");
    __syncthreads();
    if (threadIdx.x == 0) {
        unsigned* bar = b.bar; asm volatile("" : "+s"(bar));
        __builtin_amdgcn_s_waitcnt(0);
        unsigned nloc = b.st[0], nx = b.st[1];
        if (nloc == 0u) { xcd_barrier_complete(bar, b.x, nloc, nx); b.st[0] = nloc; b.st[1] = nx; }
        const unsigned old = xb_add(&bar[XB_XSUB(b.x)], 1u);
        const unsigned gen = old / nloc;
        if (old + 1u == (gen + 1u) * nloc) {
            __builtin_amdgcn_fence(__ATOMIC_RELEASE, "agent");
            asm volatile("s_waitcnt vmcnt(0)" ::: "memory");
            const unsigned og = xb_add(&bar[XB_TOP], 1u);
            const unsigned tg = og / nx;
            if (og + 1u == (tg + 1u) * nx) xb_add(&bar[XB_TOPGEN], 1u);
            else XB_SPIN(xb_ld(&bar[XB_TOPGEN]) == tg, bar);
            __builtin_amdgcn_fence(__ATOMIC_ACQUIRE, "agent");
            xb_add(&bar[XB_XGEN(b.x)], 1u);
            asm volatile("s_waitcnt vmcnt(0)" ::: "memory");
        } else {
            XB_SPIN(xb_ld(&bar[XB_XGEN(b.x)]) == gen, bar);
            __builtin_amdgcn_fence(__ATOMIC_ACQUIRE, "agent");
            asm volatile("s_waitcnt vmcnt(0)" ::: "memory");
        }
    }
    __syncthreads();
}


enum { K_CVT = 0, K_NORM, K_POOLNORM, K_GEMM_MD, K_ATTN, K_GEMM_RESID, K_GEMM_GU, K_GEMM_BF16 };
constexpr int NSTEPS = 21;
#ifndef NRUN
#define NRUN NSTEPS
#endif

__global__ void __launch_bounds__(512, 2) mega(Params p) {
    extern __shared__ __attribute__((aligned(16))) unsigned char smem[];
    cg::grid_group grid = cg::this_grid();
    unsigned char* ws0 = p.ws;
    volatile LAS unsigned* xb_st = (volatile LAS unsigned*)((LAS unsigned char*)smem + 133120);
    if (threadIdx.x == 0) { xb_st[0] = 0u; xb_st[1] = 0u; xb_st[2] = 0u; xb_st[3] = 0u; }
    __syncthreads();
    (void)xcd_barrier_post((unsigned*)(ws0 + OFF_BAR), xb_st);
#define GRID_BARRIER() do { XcdBarrier b_; unsigned char* w_ = p.ws; asm volatile("" : "+s"(w_)); b_.bar = (unsigned*)(w_ + OFF_BAR); b_.x = xb_xcc_id(); \
        b_.st = (volatile LAS unsigned*)((LAS unsigned char*)smem + 133120); xcd_barrier(b_); } while (0)
    if (p.ph_hi > 1000) grid.sync();

#if MK_SINGLE
    constexpr int s_lo = 0, s_hi = NSTEPS;
#else
    const int s_lo = p.ph_lo, s_hi = p.ph_hi;
#endif
    for (int s = s_lo; s < s_hi; ++s) {
        const int kind = p.kind[s], layer = p.layer[s], sub = p.sub[s];
        unsigned char* ws = ws0; asm volatile("" : "+s"(ws));
        bf16_t* H = (bf16_t*)(ws + OFF_H);
        bf16_t* ACT = (bf16_t*)(ws + OFF_ACT);
        bf16_t* Db = (bf16_t*)(ws + OFF_D);
        bf16_t* Ob = (bf16_t*)(ws + OFF_O);
        bf16_t* KRb = (bf16_t*)(ws + OFF_KR);
        bf16_t* Qb = (bf16_t*)(ws + OFF_Q);
        bf16_t* KVb = (bf16_t*)(ws + OFF_KV);
        bf16_t* XB = (bf16_t*)(ws + OFF_XB);
        float* PARTX = (float*)(ws + OFF_PARTX); float* PARTD = (float*)(ws + OFF_PARTD);
        const float* ctab = (const float*)(ws + OFF_CTAB); const float* stab = (const float*)(ws + OFF_STAB);
        const int j = layer >> 1;
#pragma unroll 1
        for (int rep = 0; rep < ((((PROBE_MASK >> kind) & 1) && (kind != K_GEMM_RESID) && (kind != K_NORM || sub != 2)) ? PROBE_REPS : 1); ++rep) {
        switch (kind) {
        case K_CVT: cvt_phase(p, smem); __syncthreads(); poolnorm_phase<float>(p.x, p.norm_mix, H, nullptr, smem); break;
        case K_NORM: final_norm_phase(XB, p.norm_final, p.out); break;
        case K_POOLNORM: poolnorm_phase<bf16_t>(XB, p.norm_mix + layer * 1024, H, PARTX, smem); break;
        case K_ATTN: at::attn_phase(Qb, KVb, KRb, ctab, stab, Ob, (char*)smem); break;
        case K_GEMM_RESID: {
            pg8::Gemm g; pg8::EpiResid E;
            if (sub == 0) { g = pg8::Gemm{H, (const bf16_t*)(ws + OFF_WPOOL) + (size_t)j * 1024 * 256, T, 1024, 256, 1024, 256, 256}; E = pg8::EpiResid{layer == 0 ? p.x : nullptr, XB, PARTX}; }
            else if (sub == 2) { g = pg8::Gemm{Ob, (const bf16_t*)(ws + OFF_WO) + (size_t)j * 1024 * 1024, T, 1024, 1024, 1024, 1024, 0}; E = pg8::EpiResid{nullptr, XB, PARTX}; }
            else { g = pg8::Gemm{ACT, (const bf16_t*)(ws + OFF_WDN) + (size_t)layer * 1024 * FF, T, 1024, FF, FF, FF, 0}; E = pg8::EpiResid{nullptr, XB, PARTX}; }
            pg8::StaticOrder S; S.init(g.M, g.N, (int)gridDim.x, opq_bid());
            pg8::gemm_phase<pg8::EpiResid>((LAS unsigned char*)smem, g, S, E);
        } break;
        case K_GEMM_MD: {
            pg8::Gemm g{XB, (const bf16_t*)(ws + OFF_WMD) + (size_t)j * 768 * 1024, T, 768, 1024, 1024, 1024, 0};
            pg8::EpiMdown E{Db, KRb, PARTX, PARTD, ctab, stab};
            pg8::StaticOrder S; S.init(g.M, g.N, (int)gridDim.x, opq_bid());
            pg8::gemm_phase<pg8::EpiMdown>((LAS unsigned char*)smem, g, S, E);
        } break;
        case K_GEMM_GU: {
            pg8::Gemm g{XB, (const bf16_t*)(ws + OFF_WGU) + (size_t)layer * 5632 * 1024, T, 5632, 1024, 1024, 1024, 0};
            pg8::EpiSwiglu E{ACT, FF, PARTX, (LAS float*)((LAS unsigned char*)smem + 131072)};
            pg8::StaticOrder S; S.init(g.M, g.N, (int)gridDim.x, opq_bid());
            pg8::gemm_phase<pg8::EpiSwiglu>((LAS unsigned char*)smem, g, S, E);
        } break;
        case K_GEMM_BF16: {
#pragma unroll 1
            for (int w = 0; w < 2; ++w) {
                pg8::Gemm g; pg8::EpiBf16 E;
                if (w == 0) { g = pg8::Gemm{Db, (const bf16_t*)(ws + OFF_WUQ) + (size_t)j * 1536 * 384, T, 1536, 384, 640, 384, 0}; E = pg8::EpiBf16{Qb, 1536, PARTD, 0, 2, 1.0f / 384.0f}; }
                else { g = pg8::Gemm{Db + 384, (const bf16_t*)(ws + OFF_WUKV) + (size_t)j * 2048 * 128, T, 2048, 128, 640, 128, 0}; E = pg8::EpiBf16{KVb, 2048, PARTD, 8, 1, 1.0f / 128.0f}; }
                pg8::StaticOrder S; S.init(g.M, g.N, (int)gridDim.x, opq_bid());
                pg8::gemm_phase<pg8::EpiBf16>((LAS unsigned char*)smem, g, S, E);
            }
        } break;
        default: break;
        }
        if (rep + 1 < ((((PROBE_MASK >> kind) & 1) && (kind != K_GEMM_RESID) && (kind != K_NORM || sub != 2)) ? PROBE_REPS : 1)) GRID_BARRIER();
        }
        if (s + 1 < s_hi) GRID_BARRIER();
    }
}


extern "C" void kernel_launch(void* const* d_in, const int* in_sizes, int n_in, void* d_out, int out_size, void* d_ws, size_t ws_size, hipStream_t stream) {
    static int grid_blocks = 0;
    if (grid_blocks == 0) {
        if (n_in != 16 || in_sizes[0] != T * DM || out_size != T * DM || ws_size < WS_END) {
            fprintf(stderr, "kernel_launch: unexpected shapes (n_in %d, in0 %d, out %d, ws %zu, need %zu)\n", n_in, n_in > 0 ? in_sizes[0] : -1, out_size, ws_size, (size_t)WS_END);
            grid_blocks = -1; return; }
        int dev = 0, cus = 0, per_cu = 0;
        (void)hipGetDevice(&dev);
        if (hipDeviceGetAttribute(&cus, hipDeviceAttributeMultiprocessorCount, dev) != hipSuccess || cus <= 0) cus = 256;
        if (hipFuncSetAttribute((const void*)mega, hipFuncAttributeMaxDynamicSharedMemorySize, LDS_BYTES) != hipSuccess) fprintf(stderr, "kernel_launch: hipFuncSetAttribute failed\n");
        if (hipOccupancyMaxActiveBlocksPerMultiprocessor(&per_cu, (const void*)mega, 512, LDS_BYTES) != hipSuccess || per_cu < 1) { fprintf(stderr, "kernel_launch: occupancy query gave %d\n", per_cu); per_cu = 1; }
        (void)hipGetLastError();
        grid_blocks = cus * per_cu;
    }
    if (grid_blocks < 0) return;
    Params p{};
    p.x = (const float*)d_in[0]; p.pos = (const int*)d_in[1]; p.norm_mix = (const float*)d_in[2]; p.norm_ffn = (const float*)d_in[3]; p.norm_final = (const float*)d_in[4];
    p.pool_w = (const float*)d_in[5]; p.pool_scale = (const float*)d_in[6]; p.w_down = (const float*)d_in[7]; p.q_norm = (const float*)d_in[8]; p.w_uq = (const float*)d_in[9];
    p.kv_norm = (const float*)d_in[10]; p.w_ukv = (const float*)d_in[11]; p.w_o = (const float*)d_in[12]; p.w_gate = (const float*)d_in[13]; p.w_up = (const float*)d_in[14]; p.w_dn = (const float*)d_in[15];
    p.out = (float*)d_out; p.ws = (unsigned char*)d_ws;
    { int n = 0;
#define ADD(k, l, sb) do { p.kind[n] = (unsigned char)(k); p.layer[n] = (unsigned char)(l); p.sub[n] = (unsigned char)(sb); ++n; } while (0)
      ADD(K_CVT, 0, 0);
      for (int l = 0; l < 4; ++l) {
          if ((l & 1) == 0) { if (l > 0) ADD(K_POOLNORM, l, 0); ADD(K_GEMM_RESID, l, 0); }
          else { ADD(K_GEMM_MD, l, 0); ADD(K_GEMM_BF16, l, 0); ADD(K_ATTN, l, 0); ADD(K_GEMM_RESID, l, 2); }
          ADD(K_GEMM_GU, l, 0); ADD(K_GEMM_RESID, l, 3);
      }
      ADD(K_NORM, 0, 2);
#undef ADD
      if (n != NSTEPS) fprintf(stderr, "kernel_launch: step program has %d steps, expected %d\n", n, NSTEPS); }
#if MK_SINGLE
    p.ph_lo = 0; p.ph_hi = NSTEPS;
    (void)hipMemsetAsync((char*)d_ws + OFF_BAR, 0, 16384, stream);
    void* args[] = {&p};
    hipError_t e = hipLaunchCooperativeKernel((const void*)mega, dim3(grid_blocks), dim3(512), args, LDS_BYTES, stream);
    if (e != hipSuccess) fprintf(stderr, "cooperative launch failed: %s (grid %d)\n", hipGetErrorString(e), grid_blocks);
#else
    for (int s = 0; s < NRUN; ++s) {
        p.ph_lo = s; p.ph_hi = s + 1;
        hipLaunchKernelGGL(mega, dim3(grid_blocks), dim3(512), LDS_BYTES, stream, p);
    }
#endif
}
```

```cpp
#include <hip/hip_runtime.h>
#include <hip/hip_cooperative_groups.h>
#include <cstdio>
#include <cstdint>
namespace cg = cooperative_groups;

#ifndef MK_SINGLE
#define MK_SINGLE 1
#endif
#ifndef PROBE_MASK
#define PROBE_MASK 0
#define PROBE_REPS 2
#endif
#ifndef MK_DEBUG
#define MK_DEBUG 0
#endif
#ifndef DBG_IGNORE
#define DBG_IGNORE 0ull
#endif


typedef unsigned short bf16_t;
typedef short bf16x8 __attribute__((ext_vector_type(8)));
typedef short s16x4 __attribute__((ext_vector_type(4)));
typedef float f32x4 __attribute__((ext_vector_type(4)));
typedef float f32x16 __attribute__((ext_vector_type(16)));
typedef unsigned u32x4 __attribute__((ext_vector_type(4)));
typedef unsigned u32x2 __attribute__((ext_vector_type(2)));
#define LAS __attribute__((address_space(3)))

constexpr int T = 32768, DM = 1024, SEQ = 4096, FF = 2816;
constexpr float EPS = 1e-6f;

constexpr size_t OFF_WPOOL = 0;
constexpr size_t OFF_WMD   = OFF_WPOOL + (size_t)2 * 1024 * 256 * 2;
constexpr size_t OFF_WUQ   = OFF_WMD + (size_t)2 * 768 * 1024 * 2;
constexpr size_t OFF_WUKV  = OFF_WUQ + (size_t)2 * 1536 * 384 * 2;
constexpr size_t OFF_WO    = OFF_WUKV + (size_t)2 * 2048 * 256 * 2;
constexpr size_t OFF_WGU   = OFF_WO + (size_t)2 * 1024 * 1024 * 2;
constexpr size_t OFF_WDN   = OFF_WGU + (size_t)4 * 5632 * 1024 * 2;
constexpr size_t OFF_CTAB  = OFF_WDN + (size_t)4 * 1024 * 2816 * 2;
constexpr size_t OFF_STAB  = OFF_CTAB + (size_t)T * 32 * 4;
constexpr size_t OFF_H     = OFF_STAB + (size_t)T * 32 * 4;
constexpr size_t OFF_BIG   = OFF_H + (size_t)T * 1024 * 2;
constexpr size_t OFF_ACT   = OFF_BIG;
constexpr size_t OFF_D     = OFF_BIG;
constexpr size_t OFF_O     = OFF_BIG;
constexpr size_t OFF_KR    = OFF_BIG + (size_t)T * 1024 * 2;
constexpr size_t OFF_Q     = OFF_KR + (size_t)T * 64 * 2;
constexpr size_t OFF_KV    = OFF_Q + (size_t)T * 1536 * 2;

constexpr size_t OFF_PARTX = OFF_KV + (size_t)T * 2048 * 2;
constexpr size_t OFF_PARTD = OFF_PARTX + (size_t)T * 16 * 4;
constexpr size_t OFF_BAR   = OFF_PARTD + (size_t)T * 16 * 4;
constexpr size_t OFF_XB    = OFF_BAR + 16384;
constexpr size_t WS_END    = OFF_XB + (size_t)T * 1024 * 2;
static_assert(WS_END <= (size_t)536870912, "workspace");

constexpr int LDS_BYTES = 133120 + 64;

struct Params {
    const float* x; const int* pos; const float* norm_mix; const float* norm_ffn; const float* norm_final;
    const float* pool_w; const float* pool_scale; const float* w_down; const float* q_norm; const float* w_uq;
    const float* kv_norm; const float* w_ukv; const float* w_o; const float* w_gate; const float* w_up; const float* w_dn;
    float* out; unsigned char* ws; int ph_lo, ph_hi;
    unsigned char kind[32], layer[32], sub[32];
};

__device__ __forceinline__ unsigned cvtpk(float lo, float hi) {
    unsigned r; asm volatile("v_cvt_pk_bf16_f32 %0, %1, %2" : "=v"(r) : "v"(lo), "v"(hi)); return r;
}
__device__ __forceinline__ float bf2f(short v) { return __uint_as_float(((unsigned)(unsigned short)v) << 16); }
__device__ __forceinline__ bf16x8 pack8(f32x4 a, f32x4 b) {
    u32x4 w = {cvtpk(a[0], a[1]), cvtpk(a[2], a[3]), cvtpk(b[0], b[1]), cvtpk(b[2], b[3])};
    return *reinterpret_cast<bf16x8*>(&w);
}
__device__ __forceinline__ f32x4 ld4(const float* p) { return *(const f32x4*)p; }
__device__ __forceinline__ f32x4 ld4(const bf16_t* p) { const u32x2 w = *(const u32x2*)p; return f32x4{__uint_as_float(w.x << 16), __uint_as_float(w.x & 0xffff0000u), __uint_as_float(w.y << 16), __uint_as_float(w.y & 0xffff0000u)}; }
__device__ __forceinline__ float2 ld2(const float* p) { return *(const float2*)p; }
__device__ __forceinline__ float2 ld2(const bf16_t* p) { const unsigned w = *(const unsigned*)p; return make_float2(__uint_as_float(w << 16), __uint_as_float(w & 0xffff0000u)); }
__device__ __forceinline__ int opq_tid() { int t = threadIdx.x; asm volatile("" : "+v"(t)); return t; }
__device__ __forceinline__ int opq_bid() { int b = blockIdx.x; asm volatile("" : "+s"(b)); return b; }
__device__ __forceinline__ float wave_sum(float v) {
#pragma unroll
    for (int off = 32; off >= 1; off >>= 1) v += __shfl_xor(v, off);
    return v;
}

namespace pg8 {
constexpr int BM = 256, BK = 64, HALF = 128, HTB = HALF * BK * 2, NXCD = 8, WGM = 8;
__device__ __forceinline__ int lds_byte(int r, int c) { const int st = (r >> 4) * 2 + (c >> 5), rr = r & 15, cc = c & 31, ob = rr * 64 + cc * 2; return st * 1024 + (ob ^ (((ob >> 9) & 1) << 5)); }
__device__ __forceinline__ void stage_rc(int b, int& R, int& C) { const int st = b / 1024, sb = b % 1024, swz = sb ^ (((sb >> 9) & 1) << 5); R = (st >> 1) * 16 + swz / 64; C = (st & 1) * 32 + (swz % 64) / 2; }
__device__ __forceinline__ int perm32(int rho) { const int n = rho >> 4, i = rho & 15; return 8 * (i >> 2) + 4 * n + (i & 3); }
struct Unit { int pm, pn; };
struct Gemm { const bf16_t* A; const bf16_t* Bt; int M, N, K, lda, ldb, a_pn_off; };
struct StaticOrder {
    int nM, nN, nwg, G, c;
    __device__ void init(int M, int N, int G_, int c_) { nM = M / BM; nN = N / BM; nwg = nM * nN; G = G_; c = c_; }
    __device__ bool next(int i, Unit& u) const {
        const long L = (long)i * G + c; if (L >= nwg) return false;
        int wgid = (int)L; { const int q = nwg / NXCD, r = nwg % NXCD, xcd = wgid % NXCD, off = wgid / NXCD; wgid = (xcd < r ? xcd * (q + 1) : r * (q + 1) + (xcd - r) * q) + off; }
        const int nig = WGM * nN, gid = wgid / nig, fm = gid * WGM, gsz = (nM - fm) < WGM ? (nM - fm) : WGM;
        u.pm = fm + ((wgid % nig) % gsz); u.pn = (wgid % nig) / gsz; return true;
    }
};
__device__ __forceinline__ void rows_rstd(float (&rstd)[2][4], const float* part, int row0, int s0, int nq4, float invn, int fq) {
    f32x4 t[2][4]; const int q = fq < nq4 ? fq : nq4 - 1;
#pragma unroll
    for (int ai = 0; ai < 2; ++ai)
#pragma unroll
        for (int m = 0; m < 4; ++m) t[ai][m] = *(const f32x4*)(part + (size_t)(row0 + ai * HALF + m * 16) * 16 + s0 + q * 4);
#pragma unroll
    for (int ai = 0; ai < 2; ++ai)
#pragma unroll
        for (int m = 0; m < 4; ++m) { float ss = (t[ai][m][0] + t[ai][m][1]) + (t[ai][m][2] + t[ai][m][3]); ss = fq < nq4 ? ss : 0.f;
            ss += __shfl_xor(ss, 16); ss += __shfl_xor(ss, 32); rstd[ai][m] = rsqrtf(ss * invn + EPS); }
}
struct EpiResid {
    static constexpr bool PERM = false;
    const float* Rf; bf16_t* XB; float* PART;
    typedef int State;
    __device__ __forceinline__ void row_out(const f32x4 (&acc)[2][2][4][2], const f32x4 (&rv)[2][2], int ai, int m, int row, int col0, int slot, int fq) const {
        const size_t ro = (size_t)row * 1024 + col0; float ss = 0.f;
#pragma unroll
        for (int bj = 0; bj < 2; ++bj)
#pragma unroll
            for (int n = 0; n < 2; ++n) { const int cofs = bj * HALF + n * 16;
                const f32x4 v = acc[ai][bj][m][n] + rv[bj][n];
                ss += (v[0] * v[0] + v[1] * v[1]) + (v[2] * v[2] + v[3] * v[3]);
                u32x2 w = {cvtpk(v[0], v[1]), cvtpk(v[2], v[3])}; *(u32x2*)(XB + ro + cofs) = w; }
        ss += __shfl_xor(ss, 16); ss += __shfl_xor(ss, 32);
        if (fq == 0) PART[(size_t)row * 16 + slot] = ss;
    }
    __device__ __forceinline__ void operator()(const f32x4 (&acc)[2][2][4][2], const Unit& u, int wr, int wc, int fr, int fq, State&) const {
        const int row0 = u.pm * BM + wr * 64 + fr, col0 = u.pn * BM + wc * 32 + 4 * fq, slot = u.pn * 4 + wc;
        if (Rf) {
#pragma unroll
            for (int ai = 0; ai < 2; ++ai)
#pragma unroll
                for (int mp = 0; mp < 2; ++mp) { f32x4 rv[2][2][2];
#pragma unroll
                    for (int mm = 0; mm < 2; ++mm)
#pragma unroll
                        for (int bj = 0; bj < 2; ++bj)
#pragma unroll
                            for (int n = 0; n < 2; ++n) rv[mm][bj][n] = ld4(Rf + (size_t)(row0 + ai * HALF + (mp * 2 + mm) * 16) * 1024 + col0 + bj * HALF + n * 16);
#pragma unroll
                    for (int mm = 0; mm < 2; ++mm) row_out(acc, rv[mm], ai, mp * 2 + mm, row0 + ai * HALF + (mp * 2 + mm) * 16, col0, slot, fq); }
        } else {
#pragma unroll
            for (int ai = 0; ai < 2; ++ai) { u32x2 rw[4][2][2];
#pragma unroll
                for (int m = 0; m < 4; ++m)
#pragma unroll
                    for (int bj = 0; bj < 2; ++bj)
#pragma unroll
                        for (int n = 0; n < 2; ++n) rw[m][bj][n] = *(const u32x2*)(XB + (size_t)(row0 + ai * HALF + m * 16) * 1024 + col0 + bj * HALF + n * 16);
#pragma unroll
                for (int m = 0; m < 4; ++m) { f32x4 rv[2][2];
#pragma unroll
                    for (int bj = 0; bj < 2; ++bj)
#pragma unroll
                        for (int n = 0; n < 2; ++n) { const u32x2 w = rw[m][bj][n]; rv[bj][n] = f32x4{__uint_as_float(w.x << 16), __uint_as_float(w.x & 0xffff0000u), __uint_as_float(w.y << 16), __uint_as_float(w.y & 0xffff0000u)}; }
                    row_out(acc, rv, ai, m, row0 + ai * HALF + m * 16, col0, slot, fq); } }
        }
    }
};
struct EpiMdown {
    static constexpr bool PERM = false;
    bf16_t* D; bf16_t* KR; const float* PARTX; float* PARTD; const float* ctab; const float* stab;
    typedef int State;
    __device__ __forceinline__ void operator()(const f32x4 (&acc)[2][2][4][2], const Unit& u, int wr, int wc, int fr, int fq, State&) const {
        const int row0 = u.pm * BM + wr * 64 + fr, col0 = u.pn * BM + wc * 32 + 4 * fq;
        float rs[2][4]; rows_rstd(rs, PARTX, row0, 0, 4, 1.0f / 1024.0f, fq);
        const bool rope = (u.pn == 2) && (wc < 2); const int ri = wc * 16 + 4 * fq;
#pragma unroll
        for (int ai = 0; ai < 2; ++ai) {
            f32x4 csv[4], snv[4];
            if (rope) {
#pragma unroll
                for (int m = 0; m < 4; ++m) { const size_t to = (size_t)(row0 + ai * HALF + m * 16) * 32 + ri; csv[m] = *(const f32x4*)(ctab + to); snv[m] = *(const f32x4*)(stab + to); } }
#pragma unroll
            for (int m = 0; m < 4; ++m) { const int row = row0 + ai * HALF + m * 16; const float rstd = rs[ai][m];
                float s0 = 0.f, s1 = 0.f; f32x4 vv[2][2];
#pragma unroll
                for (int bj = 0; bj < 2; ++bj)
#pragma unroll
                    for (int n = 0; n < 2; ++n) { const int c = col0 + bj * HALF + n * 16; const f32x4 v = acc[ai][bj][m][n] * rstd; vv[bj][n] = v;
                        if (c < 640) { u32x2 w = {cvtpk(v[0], v[1]), cvtpk(v[2], v[3])}; *(u32x2*)(D + (size_t)row * 640 + c) = w; }
                        const float q = (v[0] * v[0] + v[1] * v[1]) + (v[2] * v[2] + v[3] * v[3]);
                        if (bj == 0) s0 += q; else s1 += q; }
                s0 += __shfl_xor(s0, 16); s0 += __shfl_xor(s0, 32); s1 += __shfl_xor(s1, 16); s1 += __shfl_xor(s1, 32);
                if (u.pn == 0) { if (fq == 0) PARTD[(size_t)row * 16 + wc] = s0 + s1; }
                else if (u.pn == 1) { if (fq == 0) { PARTD[(size_t)row * 16 + 4 + wc] = s0; PARTD[(size_t)row * 16 + 8 + wc] = s1; } }
                else if (rope) {
                    const int i = ri; const f32x4 cs = csv[m], sn = snv[m];
                    const f32x4 x1 = vv[0][0], x2 = vv[0][1]; const f32x4 y1 = x1 * cs - x2 * sn, y2 = x2 * cs + x1 * sn;
                    u32x2 w1 = {cvtpk(y1[0], y1[1]), cvtpk(y1[2], y1[3])}, w2 = {cvtpk(y2[0], y2[1]), cvtpk(y2[2], y2[3])};
                    *(u32x2*)(KR + (size_t)row * 64 + i) = w1; *(u32x2*)(KR + (size_t)row * 64 + 32 + i) = w2; } } }
    }
};
struct EpiBf16 {
    static constexpr bool PERM = true;
    bf16_t* O; int ldc; const float* PART; int s0, nq4; float invn;
    typedef int State;
    __device__ __forceinline__ void operator()(const f32x4 (&acc)[2][2][4][2], const Unit& u, int wr, int wc, int fr, int fq, State&) const {
        const int row0 = u.pm * BM + wr * 64 + fr, col0 = u.pn * BM + wc * 32 + 8 * fq;
        float rs[2][4]; rows_rstd(rs, PART, row0, s0, nq4, invn, fq);
#pragma unroll
        for (int ai = 0; ai < 2; ++ai)
#pragma unroll
            for (int m = 0; m < 4; ++m) { const int row = row0 + ai * HALF + m * 16; const float rstd = rs[ai][m];
                bf16_t* rowp = O + (size_t)row * ldc + col0;
#pragma unroll
                for (int bj = 0; bj < 2; ++bj) { const f32x4 v0 = acc[ai][bj][m][0] * rstd, v1 = acc[ai][bj][m][1] * rstd;
                    u32x4 w; w.x = cvtpk(v0[0], v0[1]); w.y = cvtpk(v0[2], v0[3]); w.z = cvtpk(v1[0], v1[1]); w.w = cvtpk(v1[2], v1[3]);
                    *(u32x4*)(rowp + bj * HALF) = w; } }
    }
};
__device__ __forceinline__ f32x4 silu_mul4(f32x4 g, f32x4 u) {
    const f32x4 t = g * (-1.4426950408889634f); f32x4 e;
#pragma unroll
    for (int i = 0; i < 4; ++i) e[i] = __builtin_amdgcn_exp2f(t[i]);
    const f32x4 d = e + 1.0f; f32x4 r;
#pragma unroll
    for (int i = 0; i < 4; ++i) r[i] = __builtin_amdgcn_rcpf(d[i]);
    return (g * u) * r;
}
struct EpiSwiglu {
    static constexpr bool PERM = true;
    bf16_t* O; int ldc; const float* PARTX; LAS float* rc;
    typedef int State;
    __device__ __forceinline__ void operator()(const f32x4 (&acc)[2][2][4][2], const Unit& u, int wr, int wc, int fr, int fq, State& st) const {
        const int row0 = u.pm * BM + wr * 64 + fr, col0 = u.pn * HALF + wc * 32 + 8 * fq;
        float rs[2][4];
        if (st != u.pm) { rows_rstd(rs, PARTX, row0, 0, 4, 1.0f / 1024.0f, fq); st = u.pm;
#pragma unroll
            for (int ai = 0; ai < 2; ++ai)
#pragma unroll
                for (int m = 0; m < 4; ++m) rc[wr * 64 + ai * HALF + m * 16 + fr] = rs[ai][m]; }
        else {
#pragma unroll
            for (int ai = 0; ai < 2; ++ai)
#pragma unroll
                for (int m = 0; m < 4; ++m) rs[ai][m] = rc[wr * 64 + ai * HALF + m * 16 + fr]; }
#pragma unroll
        for (int ai = 0; ai < 2; ++ai)
#pragma unroll
            for (int m = 0; m < 4; ++m) { const int row = row0 + ai * HALF + m * 16; const float rstd = rs[ai][m];
                bf16_t* rowp = O + (size_t)row * ldc + col0;
                const f32x4 a0 = silu_mul4(acc[ai][0][m][0] * rstd, acc[ai][1][m][0] * rstd), a1 = silu_mul4(acc[ai][0][m][1] * rstd, acc[ai][1][m][1] * rstd);
                u32x4 w; w.x = cvtpk(a0[0], a0[1]); w.y = cvtpk(a0[2], a0[3]); w.z = cvtpk(a1[0], a1[1]); w.w = cvtpk(a1[2], a1[3]);
                *(u32x4*)rowp = w; }
    }
};

template <class Epi>
__device__ __forceinline__ void gemm_phase(LAS unsigned char* lds, const Gemm g, const StaticOrder& S, const Epi& E) {
    const int tid = opq_tid(), wid = __builtin_amdgcn_readfirstlane(tid >> 6), lane = tid & 63, wr = wid >> 2, wc = wid & 3, fr = lane & 15, fq = lane >> 4;
    const int K = g.K, nt = K / BK;
    unsigned voffA[2], voffB[2];
#pragma unroll
    for (int i = 0; i < 2; ++i) { int R, C; stage_rc(tid * 16 + i * 8192, R, C); const int Rb = Epi::PERM ? ((R & ~31) + perm32(R & 31)) : R;
        voffA[i] = (unsigned)(R * g.lda + C) * 2u; voffB[i] = (unsigned)(Rb * g.ldb + C) * 2u; }
    const size_t kstep = (size_t)(BK * 2);
    const size_t hstepA = (size_t)HALF * g.lda * 2, hstepB = (size_t)HALF * g.ldb * 2;
    const size_t tstepA = 2 * hstepA, tstepB = 2 * hstepB;
    const size_t pnA = (size_t)g.a_pn_off * 2;
    const unsigned ldsw = (unsigned)wid * 1024u;
    const int aoff = lds_byte(wr * 64 + fr, fq * 8), boff = lds_byte(wc * 32 + fr, fq * 8);
#define PG8_SA(b, h) (((b) * 2 + (h)) * HTB)
#define PG8_SB(b, h) ((4 + (b) * 2 + (h)) * HTB)
#define PG8_STAGE(bufoff, gbase, voff) do { _Pragma("unroll") for (int _i = 0; _i < 2; ++_i) \
        __builtin_amdgcn_global_load_lds((const unsigned*)((const char*)(gbase) + (voff)[_i]), (LAS unsigned*)(lds + (bufoff) + ldsw + _i * 8192), 16, 0, 0); } while (0)
#define PG8_LDA(dst, b, h) do { _Pragma("unroll") for (int m = 0; m < 4; ++m) _Pragma("unroll") for (int k = 0; k < 2; ++k) dst[m][k] = *(const LAS bf16x8*)(lds + PG8_SA(b, h) + aoff + m * 2048 + k * 1024); } while (0)
#define PG8_LDB(dst, b, h) do { _Pragma("unroll") for (int n = 0; n < 2; ++n) _Pragma("unroll") for (int k = 0; k < 2; ++k) dst[n][k] = *(const LAS bf16x8*)(lds + PG8_SB(b, h) + boff + n * 2048 + k * 1024); } while (0)
#define PG8_MMA(ai, bj, At, Bt) do { __builtin_amdgcn_s_setprio(1); _Pragma("unroll") for (int m = 0; m < 4; ++m) _Pragma("unroll") for (int n = 0; n < 2; ++n) _Pragma("unroll") for (int k = 0; k < 2; ++k) \
        acc[ai][bj][m][n] = __builtin_amdgcn_mfma_f32_16x16x32_bf16(Bt[n][k], At[m][k], acc[ai][bj][m][n], 0, 0, 0); __builtin_amdgcn_s_setprio(0); } while (0)
#define PG8_WAIT_V(n) asm volatile("s_waitcnt vmcnt(" #n ")" ::: "memory")
#define PG8_WAIT_L(n) asm volatile("s_waitcnt lgkmcnt(" #n ")" ::: "memory")
#define PG8_BAR __builtin_amdgcn_s_barrier()
#define PG8_SCHED __builtin_amdgcn_sched_barrier(0)
    Unit cur, nxt; int ui = 0;
    if (!S.next(0, cur)) return;
    typename Epi::State est; *(int*)&est = -1;
    f32x4 acc[2][2][4][2];
#pragma unroll
    for (int a = 0; a < 2; ++a)
#pragma unroll
        for (int b = 0; b < 2; ++b)
#pragma unroll
            for (int m = 0; m < 4; ++m)
#pragma unroll
                for (int n = 0; n < 2; ++n) acc[a][b][m][n] = (f32x4){0.f, 0.f, 0.f, 0.f};
    bf16x8 At[4][2], B0[2][2], B1[2][2];
    const char* cA = (const char*)g.A + (size_t)cur.pm * tstepA + (size_t)cur.pn * pnA; const char* cB = (const char*)g.Bt + (size_t)cur.pn * tstepB;
    PG8_STAGE(PG8_SB(0, 0), cB, voffB); PG8_STAGE(PG8_SA(0, 0), cA, voffA); PG8_STAGE(PG8_SB(0, 1), cB + hstepB, voffB); PG8_STAGE(PG8_SA(0, 1), cA + hstepA, voffA);
    if (wr == 1) PG8_BAR;
    PG8_WAIT_V(4); PG8_BAR;
    PG8_STAGE(PG8_SB(1, 0), cB + kstep, voffB); PG8_STAGE(PG8_SA(1, 0), cA + kstep, voffA); PG8_STAGE(PG8_SB(1, 1), cB + hstepB + kstep, voffB);
    PG8_WAIT_V(6); PG8_BAR;
    for (;;) {
        const bool has_next = S.next(ui + 1, nxt);
        const char* nA = has_next ? (const char*)g.A + (size_t)nxt.pm * tstepA + (size_t)nxt.pn * pnA : cA; const char* nB = has_next ? (const char*)g.Bt + (size_t)nxt.pn * tstepB : cB;
        for (int t = 0; t < nt; t += 2) {
            const bool last = (t == nt - 2);
            const char* a1 = cA + (size_t)(t + 1) * kstep;
            const char* a2 = last ? nA : cA + (size_t)(t + 2) * kstep; const char* b2 = last ? nB : cB + (size_t)(t + 2) * kstep;
            const char* a3 = a2 + kstep; const char* b3 = b2 + kstep;
            PG8_LDB(B0, 0, 0); PG8_SCHED; PG8_LDA(At, 0, 0); PG8_STAGE(PG8_SA(1, 1), a1 + hstepA, voffA);
            PG8_WAIT_L(8); PG8_BAR; PG8_WAIT_L(0); PG8_MMA(0, 0, At, B0); PG8_BAR; PG8_SCHED;
            PG8_LDB(B1, 0, 1); PG8_STAGE(PG8_SB(0, 0), b2, voffB);
            PG8_BAR; PG8_WAIT_L(0); PG8_MMA(0, 1, At, B1); PG8_BAR;
            PG8_LDA(At, 0, 1); PG8_STAGE(PG8_SA(0, 0), a2, voffA);
            PG8_BAR; PG8_WAIT_L(0); PG8_MMA(1, 0, At, B0); PG8_BAR; PG8_SCHED;
            PG8_STAGE(PG8_SB(0, 1), b2 + hstepB, voffB);
            PG8_WAIT_V(6); PG8_BAR; PG8_MMA(1, 1, At, B1); PG8_BAR;
            PG8_LDB(B0, 1, 0); PG8_SCHED; PG8_LDA(At, 1, 0); PG8_STAGE(PG8_SA(0, 1), a2 + hstepA, voffA);
            PG8_WAIT_L(8); PG8_BAR; PG8_WAIT_L(0); PG8_MMA(0, 0, At, B0); PG8_BAR; PG8_SCHED;
            PG8_LDB(B1, 1, 1); PG8_STAGE(PG8_SB(1, 0), b3, voffB);
            PG8_BAR; PG8_WAIT_L(0); PG8_MMA(0, 1, At, B1); PG8_BAR;
            PG8_LDA(At, 1, 1); PG8_STAGE(PG8_SA(1, 0), a3, voffA);
            PG8_BAR; PG8_WAIT_L(0); PG8_MMA(1, 0, At, B0); PG8_BAR; PG8_SCHED;
            PG8_STAGE(PG8_SB(1, 1), b3 + hstepB, voffB);
            PG8_WAIT_V(6); PG8_BAR; PG8_MMA(1, 1, At, B1); PG8_BAR;
        }
        E(acc, cur, wr, wc, fr, fq, est);
        if (!has_next) break;
#pragma unroll
        for (int a = 0; a < 2; ++a)
#pragma unroll
            for (int b = 0; b < 2; ++b)
#pragma unroll
                for (int m = 0; m < 4; ++m)
#pragma unroll
                    for (int n = 0; n < 2; ++n) acc[a][b][m][n] = (f32x4){0.f, 0.f, 0.f, 0.f};
        cur = nxt; cA = nA; cB = nB; ++ui;
    }
    PG8_WAIT_V(0);
    if (wr == 0) PG8_BAR;
    PG8_BAR;
#undef PG8_SA
#undef PG8_SB
#undef PG8_STAGE
#undef PG8_LDA
#undef PG8_LDB
#undef PG8_MMA
#undef PG8_WAIT_V
#undef PG8_WAIT_L
#undef PG8_BAR
#undef PG8_SCHED
}
}

namespace at {
constexpr float SCALE = 0.07216878364870322f;
constexpr float THR = 8.f;
constexpr int SHM_V = 16384, SHM_K = 16384, SHM_KR = 8192;
#define KSWZ(row, colB) ((row) * 256 + ((colB) ^ (((row) & 7) << 4)))
#define SBAR() __builtin_amdgcn_sched_barrier(0)
__device__ __forceinline__ int v_st(int k, int c) { const int kk = (k & ~0xC) | ((k & 4) << 1) | ((k & 8) >> 1); return ((kk >> 3) * 4 + (c >> 5)) * 512 + ((kk & 7) * 32 + (c & 31)) * 2; }
__device__ __forceinline__ int v_rd_base(int lane) { return ((lane & 3) << 3) | (((lane >> 2) & 3) << 6) | (((lane >> 4) & 1) << 5) | (((lane >> 5) & 1) << 8); }
constexpr int v_rd_off(int d0, int ks, int half) { return d0 * 512 + ks * 4096 + half * 2048; }
__device__ __forceinline__ int crow(int r, int hi) { return (r & 3) + 8 * (r >> 2) + 4 * hi; }
__device__ __forceinline__ void mask_tile(f32x16& p0, f32x16& p1, int dq, unsigned W) {
    const float NEG = -__builtin_inff();
#pragma unroll
    for (int r = 0; r < 16; ++r) {
        const int c = (r & 3) + 8 * (r >> 2);
        if ((unsigned)(dq - c) >= W) p0[r] = NEG;
        if ((unsigned)(dq - c - 32) >= W) p1[r] = NEG;
    }
}
__device__ __forceinline__ void partialSM(f32x16& p0, f32x16& p1, float& m_reg, float& mn, float& alpha) {
    float pmax = p0[0];
#pragma unroll
    for (int r = 1; r < 16; ++r) pmax = fmaxf(pmax, p0[r]);
#pragma unroll
    for (int r = 0; r < 16; ++r) pmax = fmaxf(pmax, p1[r]);
    { auto rr = __builtin_amdgcn_permlane32_swap(__float_as_uint(pmax), __float_as_uint(pmax), false, false);
      pmax = fmaxf(__uint_as_float(rr[0]), __uint_as_float(rr[1])); }
    constexpr float C2 = 1.4426950408889634f * SCALE;
    if (__builtin_expect(__all((pmax - m_reg) * SCALE <= THR), 1)) { mn = m_reg; alpha = 1.f; }
    else { mn = fmaxf(m_reg, pmax); alpha = __builtin_amdgcn_exp2f((m_reg - mn) * C2); m_reg = mn; }
    const float mnL = -mn * C2;
#pragma unroll
    for (int r = 0; r < 16; ++r) p0[r] = fmaf(p0[r], C2, mnL);
#pragma unroll
    for (int r = 0; r < 16; ++r) p1[r] = fmaf(p1[r], C2, mnL);
#pragma unroll
    for (int r = 0; r < 16; ++r) p0[r] = __builtin_amdgcn_exp2f(p0[r]);
}
__device__ __forceinline__ void finishSM(f32x16& p0, f32x16& p1, float alpha, float& l_reg, bf16x8& pa0, bf16x8& pa1, bf16x8& pa2, bf16x8& pa3) {
#pragma unroll
    for (int r = 0; r < 16; ++r) p1[r] = __builtin_amdgcn_exp2f(p1[r]);
    float ps = 0;
#pragma unroll
    for (int r = 0; r < 16; ++r) ps += p0[r];
#pragma unroll
    for (int r = 0; r < 16; ++r) ps += p1[r];
    { auto rr = __builtin_amdgcn_permlane32_swap(__float_as_uint(ps), __float_as_uint(ps), false, false);
      ps = __uint_as_float(rr[0]) + __uint_as_float(rr[1]); }
    l_reg = l_reg * alpha + ps;
#define PK4(P, B_, OUT) do { unsigned a0 = cvtpk(P[B_+0], P[B_+1]), a1 = cvtpk(P[B_+2], P[B_+3]);                          \
        unsigned b0 = cvtpk(P[B_+4], P[B_+5]), b1 = cvtpk(P[B_+6], P[B_+7]);                                             \
        auto r0 = __builtin_amdgcn_permlane32_swap(a0, b0, false, false); auto r1 = __builtin_amdgcn_permlane32_swap(a1, b1, false, false); \
        u32x4 w = {r0[0], r1[0], r0[1], r1[1]}; OUT = *reinterpret_cast<bf16x8*>(&w); } while (0)
    PK4(p0, 0, pa0); PK4(p0, 8, pa1); PK4(p1, 0, pa2); PK4(p1, 8, pa3);
#undef PK4
}
__device__ __forceinline__ void qkt(f32x16& p0, f32x16& p1, const char* K_lds, const char* KR_lds, const char* QR_l, int r32, int hi, const bf16x8* qr) {
    p0 = f32x16{}; p1 = f32x16{};
    const char* kb[4];
#pragma unroll
    for (int dd = 0; dd < 4; ++dd) kb[dd] = K_lds + KSWZ(r32, (dd * 16 + hi * 8) * 2);
#pragma unroll
    for (int d0 = 0; d0 < 8; ++d0) { const char* a = kb[d0 & 3] + (d0 >> 2) * 128;
        bf16x8 b0 = *reinterpret_cast<const bf16x8*>(a);
        bf16x8 b1 = *reinterpret_cast<const bf16x8*>(a + 32 * 256);
        p0 = __builtin_amdgcn_mfma_f32_32x32x16_bf16(b0, qr[d0], p0, 0, 0, 0);
        p1 = __builtin_amdgcn_mfma_f32_32x32x16_bf16(b1, qr[d0], p1, 0, 0, 0); }
#pragma unroll
    for (int d1 = 0; d1 < 4; ++d1) { const char* a = KR_lds + r32 * 128 + (((d1 * 16 + hi * 8) * 2) ^ ((r32 & 7) << 4));
        bf16x8 b0 = *reinterpret_cast<const bf16x8*>(a);
        bf16x8 b1 = *reinterpret_cast<const bf16x8*>(a + 32 * 128);
        const bf16x8 qv = *reinterpret_cast<const bf16x8*>(QR_l + d1 * 1024);
        p0 = __builtin_amdgcn_mfma_f32_32x32x16_bf16(b0, qv, p0, 0, 0, 0);
        p1 = __builtin_amdgcn_mfma_f32_32x32x16_bf16(b1, qv, p1, 0, 0, 0); }
}
__device__ __forceinline__ void pv_tile(f32x16* o, int vb0, bf16x8 pa0, bf16x8 pa1, bf16x8 pa2, bf16x8 pa3) {
#define TRRD(dst, off) asm volatile("ds_read_b64_tr_b16 %0, %1 offset:%2" : "=&v"(dst) : "v"(vb0), "i"(off) : "memory")
#define PV_D0(d0) do { s16x4 l0, l1, l2, l3, h0, h1, h2, h3; constexpr int b_ = v_rd_off(d0, 0, 0); \
        TRRD(l0, b_); TRRD(h0, b_ + 2048); TRRD(l1, b_ + 4096); TRRD(h1, b_ + 6144); TRRD(l2, b_ + 8192); TRRD(h2, b_ + 10240); TRRD(l3, b_ + 12288); TRRD(h3, b_ + 14336); \
        asm volatile("s_waitcnt lgkmcnt(0)" ::: "memory"); SBAR();   \
        o[d0] = __builtin_amdgcn_mfma_f32_32x32x16_bf16(pa0, (bf16x8){l0[0], l0[1], l0[2], l0[3], h0[0], h0[1], h0[2], h0[3]}, o[d0], 0, 0, 0);   \
        o[d0] = __builtin_amdgcn_mfma_f32_32x32x16_bf16(pa1, (bf16x8){l1[0], l1[1], l1[2], l1[3], h1[0], h1[1], h1[2], h1[3]}, o[d0], 0, 0, 0);   \
        o[d0] = __builtin_amdgcn_mfma_f32_32x32x16_bf16(pa2, (bf16x8){l2[0], l2[1], l2[2], l2[3], h2[0], h2[1], h2[2], h2[3]}, o[d0], 0, 0, 0);   \
        o[d0] = __builtin_amdgcn_mfma_f32_32x32x16_bf16(pa3, (bf16x8){l3[0], l3[1], l3[2], l3[3], h3[0], h3[1], h3[2], h3[3]}, o[d0], 0, 0, 0); } while (0)
    PV_D0(0); PV_D0(1); PV_D0(2); PV_D0(3);
#undef PV_D0
#undef TRRD
}

__device__ __forceinline__ void attn_qblock(const bf16_t* __restrict__ Q, const bf16_t* __restrict__ KV, const bf16_t* __restrict__ KR,
                                            const float* __restrict__ ctab, const float* __restrict__ stab, bf16_t* __restrict__ O,
                                            int b, int h, int qb, char* lds) {
    const int tid = opq_tid(), wid = __builtin_amdgcn_readfirstlane(tid >> 6), lane = tid & 63, r32 = lane & 31, hi = lane >> 5;
    const int P0 = qb * 256, NT = P0 / 64 + 4, tok0 = b * SEQ;
    constexpr int KBUF = SHM_K + SHM_KR, VOFF = 2 * KBUF, WOFF = VOFF + 3 * SHM_V;
    float* wsl = (float*)(lds + WOFF) + wid * 64; float* li_l = wsl; float* al_l = wsl + 32;
    char* QR_l = lds + WOFF + 2048 + wid * 4096 + lane * 16;
    const int qlo = P0 + wid * 32, qm = qlo + r32 - 4 * hi;
    const int qtok = tok0 + qlo + r32;
    bf16x8 qr[8];
    { bf16x8 qx[4];
      const bf16_t* qp = Q + (size_t)qtok * 1536 + h * 192 + hi * 8;
#pragma unroll
      for (int d0 = 0; d0 < 8; ++d0) qr[d0] = *(const bf16x8*)(qp + d0 * 16);
#pragma unroll
      for (int d0 = 0; d0 < 4; ++d0) qx[d0] = *(const bf16x8*)(qp + 128 + d0 * 16);
#pragma unroll
      for (int dd = 0; dd < 2; ++dd) {
          const int i0 = dd * 16 + hi * 8;
          const f32x4 c0 = *(const f32x4*)(ctab + (size_t)qtok * 32 + i0), c1 = *(const f32x4*)(ctab + (size_t)qtok * 32 + i0 + 4);
          const f32x4 s0 = *(const f32x4*)(stab + (size_t)qtok * 32 + i0), s1 = *(const f32x4*)(stab + (size_t)qtok * 32 + i0 + 4);
          f32x4 a0, a1, b0, b1;
#pragma unroll
          for (int e = 0; e < 4; ++e) {
              const float x1 = bf2f(qx[dd][e]), x2 = bf2f(qx[2 + dd][e]);
              a0[e] = x1 * c0[e] - x2 * s0[e]; b0[e] = x2 * c0[e] + x1 * s0[e];
              const float y1 = bf2f(qx[dd][4 + e]), y2 = bf2f(qx[2 + dd][4 + e]);
              a1[e] = y1 * c1[e] - y2 * s1[e]; b1[e] = y2 * c1[e] + y1 * s1[e];
          }
          *(bf16x8*)(QR_l + dd * 1024) = pack8(a0, a1); *(bf16x8*)(QR_l + (2 + dd) * 1024) = pack8(b0, b1);
      } }
    const int sr = tid >> 4, sc = (tid & 15) * 8, vst0 = v_st(sr, sc), vst1 = v_st(32 + sr, sc), kws = KSWZ(sr, sc * 2);
    const int rr = tid >> 3, rc = (tid & 7) * 8, krws = rr * 128 + ((rc * 2) ^ ((rr & 7) << 4));
    const int vbase = (int)(uintptr_t)lds + VOFF + v_rd_base(lane);
    const bf16_t* kvp = KV + (size_t)(tok0 + sr) * 2048 + h * 256 + sc;
    const bf16_t* krp = KR + (size_t)(tok0 + rr) * 64 + rc;
    bf16x8 st_k0, st_k1, st_v0, st_v1, st_kr;
#define LOADT(t) do { const bf16_t* p_ = kvp + (size_t)(t) * 64 * 2048; st_k0 = *(const bf16x8*)p_; st_v0 = *(const bf16x8*)(p_ + 128); \
        st_k1 = *(const bf16x8*)(p_ + 32 * 2048); st_v1 = *(const bf16x8*)(p_ + 32 * 2048 + 128); st_kr = *(const bf16x8*)(krp + (size_t)(t) * 64 * 64); } while (0)
#define WRITET(ko, vo) do { char* k_ = lds + (ko); char* v_ = lds + VOFF + (vo); *(bf16x8*)(k_ + kws) = st_k0; *(bf16x8*)(k_ + kws + 32 * 256) = st_k1; \
        *(bf16x8*)(v_ + vst0) = st_v0; *(bf16x8*)(v_ + vst1) = st_v1; *(bf16x8*)(k_ + SHM_K + krws) = st_kr; } while (0)
#define RESC(a) do { if (__any((a) < 1.f)) { if (hi == 0) al_l[r32] = (a); asm volatile("s_waitcnt lgkmcnt(0)" ::: "memory"); \
        _Pragma("unroll") for (int d_ = 0; d_ < 4; ++d_) _Pragma("unroll") for (int r = 0; r < 16; ++r) o[d_][r] *= al_l[crow(r, hi)]; } } while (0)
    float m_reg = -1e30f, l_reg = 0.f; f32x16 o[4] = {};
    f32x16 pA0 = f32x16{}, pA1 = f32x16{}, pB0 = f32x16{}, pB1 = f32x16{}; float mnA = 0.f, alA = 1.f, mnB = 0.f, alB = 1.f;
    bf16x8 pa0 = bf16x8{}, pa1 = bf16x8{}, pa2 = bf16x8{}, pa3 = bf16x8{};
    int vcur = 0, vprev = 2 * SHM_V;
#define STEP(PX0, PX1, mnX, alX, PY0, PY1, alY, t) do { \
        const int kcur_ = ((t) & 1) * KBUF, vnext_ = vcur == 2 * SHM_V ? 0 : vcur + SHM_V; \
        if ((t) + 1 < NT) { WRITET(KBUF - kcur_, vnext_); if ((t) + 2 < NT) LOADT((t) + 2); } \
        const int kb_ = (t) * 64; const bool actX_ = kb_ <= qlo + 31, actY_ = (t) > 0 && kb_ - 64 <= qlo + 31; \
        SBAR(); if (actX_) qkt(PX0, PX1, lds + kcur_, lds + kcur_ + SHM_K, QR_l, r32, hi, qr); \
        if (actY_) { finishSM(PY0, PY1, alY, l_reg, pa0, pa1, pa2, pa3); SBAR(); pv_tile(o, vbase + vprev, pa0, pa1, pa2, pa3); } \
        if (actX_) { if (kb_ + 63 > qlo) mask_tile(PX0, PX1, qm - kb_, 0x40000000u); partialSM(PX0, PX1, m_reg, mnX, alX); RESC(alX); } \
        vprev = vcur; vcur = vnext_; \
        __syncthreads(); } while (0)
    LOADT(0);
    __syncthreads();
    WRITET(0, 0);
    LOADT(1);
    __syncthreads();
    STEP(pA0, pA1, mnA, alA, pB0, pB1, alB, 0);
    for (int t = 1; t + 1 < NT; t += 2) {
        STEP(pB0, pB1, mnB, alB, pA0, pA1, alA, t);
        STEP(pA0, pA1, mnA, alA, pB0, pB1, alB, t + 1);
    }
    STEP(pB0, pB1, mnB, alB, pA0, pA1, alA, NT - 1);
    if ((NT - 1) * 64 <= qlo + 31) { finishSM(pB0, pB1, alB, l_reg, pa0, pa1, pa2, pa3); SBAR(); pv_tile(o, vbase + vprev, pa0, pa1, pa2, pa3); }
#undef STEP
#undef RESC
#undef WRITET
#undef LOADT
    if (hi == 0) li_l[r32] = l_reg; asm volatile("s_waitcnt lgkmcnt(0)" ::: "memory");
    bf16_t* Ow = O + (size_t)(tok0 + qlo) * 1024 + h * 128;
#pragma unroll
    for (int r = 0; r < 16; ++r) { const int orow = crow(r, hi); const float rli = __builtin_amdgcn_rcpf(li_l[orow]);
#pragma unroll
        for (int d0 = 0; d0 < 4; ++d0) { const float v = o[d0][r] * rli; const float vn = __shfl_xor(v, 1);
            if ((r32 & 1) == 0) *(unsigned*)(Ow + (size_t)orow * 1024 + d0 * 32 + r32) = cvtpk(v, vn); } }
}
__device__ __forceinline__ void attn_phase(const bf16_t* Q, const bf16_t* KV, const bf16_t* KR, const float* ctab, const float* stab, bf16_t* O, char* lds) {
    for (int L = blockIdx.x; L < 512; L += gridDim.x) {
        const int xcd = L & 7, k = L >> 3, bh = xcd * 8 + (k >> 3), x = k & 7;
        attn_qblock(Q, KV, KR, ctab, stab, O, bh >> 3, bh & 7, 15 - x, lds);
        attn_qblock(Q, KV, KR, ctab, stab, O, bh >> 3, bh & 7, x, lds);
    }
    __syncthreads();
}
}

__device__ __forceinline__ void cvt_phase(const Params& p, unsigned char* smem) {
    const int tid = opq_tid();
    unsigned char* ws = p.ws;
    constexpr int C_POOL = 8 * 8, C_MD = 2 * 72, C_UQ = 2 * 72, C_UKV = 2 * 32, C_WO = 2 * 128, C_G = 4 * 352;
    constexpr int TOTAL = C_POOL + C_MD + C_UQ + C_UKV + C_WO + 3 * C_G;
    for (int u = blockIdx.x; u < TOTAL; u += gridDim.x) {
        int r = u, mtx, ldsrc, lddst, ntl, kind = 0; const float* src; bf16_t* dst; const float* scale = nullptr; const float* kscale = nullptr;
        if (r < C_POOL) { mtx = r / 8; r %= 8; src = p.pool_w + (size_t)mtx * 65536; ldsrc = 256; dst = (bf16_t*)(ws + OFF_WPOOL) + (size_t)mtx * 65536; lddst = 256; ntl = 4; scale = p.pool_scale + mtx * 256; }
        else if ((r -= C_POOL) < C_MD) { mtx = r / 72; r %= 72; src = p.w_down + (size_t)mtx * 1024 * 576; ldsrc = 576; dst = (bf16_t*)(ws + OFF_WMD) + (size_t)mtx * 768 * 1024; lddst = 1024; ntl = 9; kind = 3; kscale = p.norm_mix + (2 * mtx + 1) * 1024; }
        else if ((r -= C_MD) < C_UQ) { mtx = r / 72; r %= 72; src = p.w_uq + (size_t)mtx * 384 * 1536; ldsrc = 1536; dst = (bf16_t*)(ws + OFF_WUQ) + (size_t)mtx * 1536 * 384; lddst = 384; ntl = 24; kscale = p.q_norm + mtx * 384; }
        else if ((r -= C_UQ) < C_UKV) { mtx = r / 32; r %= 32; src = p.w_ukv + (size_t)mtx * 128 * 2048; ldsrc = 2048; dst = (bf16_t*)(ws + OFF_WUKV) + (size_t)mtx * 2048 * 128; lddst = 128; ntl = 32; kscale = p.kv_norm + mtx * 128; }
        else if ((r -= C_UKV) < C_WO) { mtx = r / 128; r %= 128; src = p.w_o + (size_t)mtx * 1024 * 1024; ldsrc = 1024; dst = (bf16_t*)(ws + OFF_WO) + (size_t)mtx * 1024 * 1024; lddst = 1024; ntl = 16; }
        else if ((r -= C_WO) < C_G) { mtx = r / 352; r %= 352; src = p.w_gate + (size_t)mtx * 1024 * FF; ldsrc = FF; dst = (bf16_t*)(ws + OFF_WGU) + (size_t)mtx * 5632 * 1024; lddst = 1024; ntl = 44; kind = 1; kscale = p.norm_ffn + mtx * 1024; }
        else if ((r -= C_G) < C_G) { mtx = r / 352; r %= 352; src = p.w_up + (size_t)mtx * 1024 * FF; ldsrc = FF; dst = (bf16_t*)(ws + OFF_WGU) + (size_t)mtx * 5632 * 1024; lddst = 1024; ntl = 44; kind = 2; kscale = p.norm_ffn + mtx * 1024; }
        else { r -= C_G; mtx = r / 352; r %= 352; src = p.w_dn + (size_t)mtx * FF * 1024; ldsrc = 1024; dst = (bf16_t*)(ws + OFF_WDN) + (size_t)mtx * 1024 * FF; lddst = FF; ntl = 16; }
        const int k0 = (r / ntl) * 128 + (tid >> 6) * 16, ng = (r % ntl) * 64 + (tid & 63);
        float v[16];
#pragma unroll
        for (int i = 0; i < 16; ++i) v[i] = src[(size_t)(k0 + i) * ldsrc + ng];
        if (scale) { const float sc = scale[ng];
#pragma unroll
            for (int i = 0; i < 16; ++i) v[i] *= sc; }
        if (kscale) {
#pragma unroll
            for (int q = 0; q < 4; ++q) { const f32x4 kq = *(const f32x4*)(kscale + k0 + 4 * q);
#pragma unroll
                for (int i = 0; i < 4; ++i) v[4 * q + i] *= kq[i]; } }
        int drow = ng;
        if (kind == 1 || kind == 2) drow = (ng >> 7) * 256 + (ng & 127) + (kind == 2 ? 128 : 0);
        else if (kind == 3 && ng >= 512) { const int q = ng - 512, half = q >> 5, i2 = q & 31; drow = 512 + (i2 >> 4) * 32 + half * 16 + (i2 & 15); }
        u32x4 w0 = {cvtpk(v[0], v[1]), cvtpk(v[2], v[3]), cvtpk(v[4], v[5]), cvtpk(v[6], v[7])}, w1 = {cvtpk(v[8], v[9]), cvtpk(v[10], v[11]), cvtpk(v[12], v[13]), cvtpk(v[14], v[15])};
        *(u32x4*)(dst + (size_t)drow * lddst + k0) = w0; *(u32x4*)(dst + (size_t)drow * lddst + k0 + 8) = w1;
    }
    const int gt = blockIdx.x * 512 + tid, gn = gridDim.x * 512;
    unsigned zz = 0u; asm volatile("" : "+v"(zz)); const u32x4 z = {zz, zz, zz, zz};
    for (int i = gt; i < 2 * 192 * 128; i += gn) { const int l = i / (192 * 128), q = i % (192 * 128);
        *(u32x4*)((bf16_t*)(ws + OFF_WMD) + (size_t)l * 768 * 1024 + (size_t)576 * 1024 + (size_t)q * 8) = z; }
    float* ctab = (float*)(ws + OFF_CTAB); float* stab = (float*)(ws + OFF_STAB);
    for (int i = gt; i < T * 32; i += gn) { const int tok = i >> 5, j = i & 31;
        const float inv = 1.0f / exp2f((float)j * (13.287712379549449f / 32.0f));
        const float ang = (float)p.pos[tok] * inv;
        const double rev = (double)ang * 0.15915494309189535;
        const float fr = (float)(rev - rint(rev));
        ctab[i] = __builtin_amdgcn_cosf(fr); stab[i] = __builtin_amdgcn_sinf(fr); }
}

template <class TX>
__device__ __forceinline__ void norm_phase(const TX* x, const float* g, bf16_t* outb, float* outf) {
    const int tid = opq_tid(), lane = tid & 63, gw = blockIdx.x * 8 + (tid >> 6), nw = gridDim.x * 8;
    f32x4 gv[4];
#pragma unroll
    for (int i = 0; i < 4; ++i) gv[i] = *(const f32x4*)(g + (lane + 64 * i) * 4);
    int nw2 = nw; asm volatile("" : "+s"(nw2));
    for (int row = gw; row < T; row += 2 * nw2) {
        const int row2 = row + nw2 < T ? row + nw2 : row;
        const TX* xr = x + (size_t)row * 1024; const TX* xr2 = x + (size_t)row2 * 1024;
        f32x4 v[4], v2[4]; float ss = 0.f, ss2 = 0.f;
#pragma unroll
        for (int i = 0; i < 4; ++i) { v[i] = ld4(xr + (lane + 64 * i) * 4); v2[i] = ld4(xr2 + (lane + 64 * i) * 4); }
#pragma unroll
        for (int i = 0; i < 4; ++i) { ss += v[i][0] * v[i][0] + v[i][1] * v[i][1] + v[i][2] * v[i][2] + v[i][3] * v[i][3]; ss2 += v2[i][0] * v2[i][0] + v2[i][1] * v2[i][1] + v2[i][2] * v2[i][2] + v2[i][3] * v2[i][3]; }
        ss = wave_sum(ss); ss2 = wave_sum(ss2);
        const float rstd = rsqrtf(ss * (1.0f / 1024.0f) + EPS), rstd2 = rsqrtf(ss2 * (1.0f / 1024.0f) + EPS);
#pragma unroll
        for (int i = 0; i < 4; ++i) { const f32x4 y = v[i] * rstd * gv[i], y2 = v2[i] * rstd2 * gv[i];
            if (outb) { u32x2 w = {cvtpk(y[0], y[1]), cvtpk(y[2], y[3])}; *(u32x2*)(outb + (size_t)row * 1024 + (lane + 64 * i) * 4) = w;
                        u32x2 w2 = {cvtpk(y2[0], y2[1]), cvtpk(y2[2], y2[3])}; *(u32x2*)(outb + (size_t)row2 * 1024 + (lane + 64 * i) * 4) = w2; }
            else { *(f32x4*)(outf + (size_t)row * 1024 + (lane + 64 * i) * 4) = y; *(f32x4*)(outf + (size_t)row2 * 1024 + (lane + 64 * i) * 4) = y2; } }
    }
}

template <int WIN, class TX>
__device__ __forceinline__ void pool_rows(const TX* xc, const float* rs, float g0, float g1, bf16_t* Pc, int s0) {
    float2 h[31 + WIN];
#pragma unroll
    for (int i = 0; i < 31 + WIN; ++i) { const int j = i - (WIN - 1);
        if (s0 + j >= 0) { const float2 xv = ld2(xc + (ptrdiff_t)j * 1024); const float r = rs[16 + j]; h[i] = make_float2(xv.x * r * g0, xv.y * r * g1); }
        else h[i] = make_float2(0.f, 0.f); }
    float S0 = 0.f, S1 = 0.f;
#pragma unroll
    for (int i = 0; i < WIN - 1; ++i) { S0 += h[i].x; S1 += h[i].y; }
#pragma unroll
    for (int k = 0; k < 32; ++k) { const int i = k + WIN - 1, s = s0 + k; S0 += h[i].x; S1 += h[i].y;
        const int na = s + 1 < WIN ? s + 1 : WIN; const float inv = 1.0f / (float)na;
        *(unsigned*)(Pc + (size_t)k * 1024) = cvtpk(S0 * inv - h[i].x, S1 * inv - h[i].y);
        S0 -= h[k].x; S1 -= h[k].y; }
}
template <class TX>
__device__ __forceinline__ void poolnorm_phase(const TX* x, const float* g, bf16_t* P, const float* part, unsigned char* smem) {
    float* rs = (float*)smem;
    const int tid = opq_tid(), wid = tid >> 6, lane = tid & 63;
    const int c = tid * 2;
    const float g0 = g[c], g1 = g[c + 1];
    for (int tile = blockIdx.x; tile < T / 32; tile += gridDim.x) {
        const int t0 = tile * 32, s0 = t0 & (SEQ - 1);
        if (part) {
            if (tid < 48 && s0 - 16 + tid >= 0) { const f32x4* pp = (const f32x4*)(part + (size_t)(t0 - 16 + tid) * 16); float ss = 0.f;
#pragma unroll
                for (int i = 0; i < 4; ++i) { const f32x4 v = pp[i]; ss += (v[0] + v[1]) + (v[2] + v[3]); }
                rs[tid] = rsqrtf(ss * (1.0f / 1024.0f) + EPS); }
        } else
        { float ssq[6];
#pragma unroll
          for (int k = 0; k < 6; ++k) { const int rr = wid * 6 + k, s = s0 - 16 + rr; float ss = 0.f;
              if (s >= 0) { const TX* xr = x + (size_t)(t0 - 16 + rr) * 1024;
#pragma unroll
                  for (int i = 0; i < 4; ++i) { const f32x4 v = ld4(xr + (lane + 64 * i) * 4); ss += v[0] * v[0] + v[1] * v[1] + v[2] * v[2] + v[3] * v[3]; } }
              ssq[k] = ss; }
#pragma unroll
          for (int k = 0; k < 6; ++k) { const float ss = wave_sum(ssq[k]); if (lane == 0) rs[wid * 6 + k] = rsqrtf(ss * (1.0f / 1024.0f) + EPS); } }
        __syncthreads();
        { const TX* xc = x + (size_t)t0 * 1024 + c; bf16_t* Pc = P + (size_t)t0 * 1024 + c;
          const int grp = __builtin_amdgcn_readfirstlane(wid >> 1);
          if (grp == 0) pool_rows<2, TX>(xc, rs, g0, g1, Pc, s0); else if (grp == 1) pool_rows<4, TX>(xc, rs, g0, g1, Pc, s0);
          else if (grp == 2) pool_rows<8, TX>(xc, rs, g0, g1, Pc, s0); else pool_rows<16, TX>(xc, rs, g0, g1, Pc, s0); }
        __syncthreads();
    }
}

#define XB_TMO      128
#define XB_XCNT(j)  (256  + 64 * (j))
#define XB_XSUB(j)  (1280 + 64 * (j))
#define XB_XGEN(j)  (2304 + 64 * (j))
#define XB_TOP      3328
#define XB_TOPGEN   3392
#define XCD_BAR_WORDS 3456
#define XB_SPIN_CAP (1u << 18)

__device__ __forceinline__ unsigned xb_ld(unsigned* p)              { return __hip_atomic_load(p, __ATOMIC_RELAXED, __HIP_MEMORY_SCOPE_AGENT); }
__device__ __forceinline__ unsigned xb_add(unsigned* p, unsigned v) { return __hip_atomic_fetch_add(p, v, __ATOMIC_RELAXED, __HIP_MEMORY_SCOPE_AGENT); }
__device__ __forceinline__ unsigned xb_xcc_id() { return (unsigned)__builtin_amdgcn_s_getreg((3 << 11) | 20) & 0xFu; }
#define XB_SPIN(cond, bar) do { unsigned _sp = 0; while (cond) { __builtin_amdgcn_s_sleep(1); \
    if ((++_sp & 255u) == 0u) { if (xb_ld(&(bar)[XB_TMO])) break; if (_sp > XB_SPIN_CAP) { atomicAdd(&(bar)[XB_TMO], 1u); break; } } } } while (0)

struct XcdBarrier {
    unsigned* bar; unsigned x;
    volatile LAS unsigned* st;
};

__device__ __forceinline__ XcdBarrier xcd_barrier_post(unsigned* bar, volatile LAS unsigned* st) {
    XcdBarrier b; b.bar = bar; b.x = xb_xcc_id(); b.st = st;
    if (threadIdx.x == 0) (void)xb_add(&bar[XB_XCNT(b.x)], 1u);
    return b;
}
__device__ __forceinline__ void xcd_barrier_complete(unsigned* bar, unsigned x, unsigned& nloc, unsigned& nx) {
    const unsigned G = gridDim.x * gridDim.y * gridDim.z;
    unsigned sum, cnt, mine, sp = 0u;
    for (;;) {
        sum = 0u; cnt = 0u; mine = 0u;
#pragma unroll
        for (unsigned j = 0; j < 16; ++j) { const unsigned c = xb_ld(&bar[XB_XCNT(j)]); sum += c; cnt += (c > 0u) ? 1u : 0u; mine = (j == x) ? c : mine; }
        if (sum == G) break;
        __builtin_amdgcn_s_sleep(1);
        if ((++sp & 255u) == 0u) { if (xb_ld(&bar[XB_TMO])) break; if (sp > XB_SPIN_CAP) { atomicAdd(&bar[XB_TMO], 1u); break; } }
    }
    nloc = mine > 0u ? mine : 1u; nx = cnt > 0u ? cnt : 1u;
}

__device__ __forceinline__ void xcd_barrier(const XcdBarrier& b) {
    asm volatile("s_waitcnt vmcnt(0)" ::: "memory");
    __syncthreads();
    if (threadIdx.x == 0) {
        unsigned* bar = b.bar; asm volatile("" : "+s"(bar));
        __builtin_amdgcn_s_waitcnt(0);
        unsigned nloc = b.st[0], nx = b.st[1];
        if (nloc == 0u) { xcd_barrier_complete(bar, b.x, nloc, nx); b.st[0] = nloc; b.st[1] = nx; }
        const unsigned old = xb_add(&bar[XB_XSUB(b.x)], 1u);
        const unsigned gen = old / nloc;
        if (old + 1u == (gen + 1u) * nloc) {
            __builtin_amdgcn_fence(__ATOMIC_RELEASE, "agent");
            asm volatile("s_waitcnt vmcnt(0)" ::: "memory");
            const unsigned og = xb_add(&bar[XB_TOP], 1u);
            const unsigned tg = og / nx;
            if (og + 1u == (tg + 1u) * nx) xb_add(&bar[XB_TOPGEN], 1u);
            else XB_SPIN(xb_ld(&bar[XB_TOPGEN]) == tg, bar);
            __builtin_amdgcn_fence(__ATOMIC_ACQUIRE, "agent");
            xb_add(&bar[XB_XGEN(b.x)], 1u);
            asm volatile("s_waitcnt vmcnt(0)" ::: "memory");
        } else {
            XB_SPIN(xb_ld(&bar[XB_XGEN(b.x)]) == gen, bar);
            __builtin_amdgcn_fence(__ATOMIC_ACQUIRE, "agent");
            asm volatile("s_waitcnt vmcnt(0)" ::: "memory");
        }
    }
    __syncthreads();
}


enum { K_CVT = 0, K_NORM, K_POOLNORM, K_GEMM_MD, K_ATTN, K_GEMM_RESID, K_GEMM_GU, K_GEMM_BF16 };
constexpr int NSTEPS = 21;
#ifndef NRUN
#define NRUN NSTEPS
#endif

__global__ void __launch_bounds__(512, 2) mega(Params p) {
    extern __shared__ __attribute__((aligned(16))) unsigned char smem[];
    cg::grid_group grid = cg::this_grid();
    unsigned char* ws0 = p.ws;
    volatile LAS unsigned* xb_st = (volatile LAS unsigned*)((LAS unsigned char*)smem + 133120);
    if (threadIdx.x == 0) { xb_st[0] = 0u; xb_st[1] = 0u; xb_st[2] = 0u; xb_st[3] = 0u; }
    __syncthreads();
    (void)xcd_barrier_post((unsigned*)(ws0 + OFF_BAR), xb_st);
#define GRID_BARRIER() do { XcdBarrier b_; unsigned char* w_ = ((const __attribute__((address_space(4))) Params*)__builtin_amdgcn_kernarg_segment_ptr())->ws; asm volatile("" : "+s"(w_)); b_.bar = (unsigned*)(w_ + OFF_BAR); b_.x = xb_xcc_id(); \
        b_.st = (volatile LAS unsigned*)((LAS unsigned char*)smem + 133120); xcd_barrier(b_); } while (0)
    if (p.ph_hi > 1000) grid.sync();

#if MK_SINGLE
    constexpr int s_lo = 0, s_hi = NSTEPS;
#else
    const int s_lo = p.ph_lo, s_hi = p.ph_hi;
#endif
    for (int s = s_lo; s < s_hi; ++s) {
        typedef const __attribute__((address_space(4))) Params* KargP;
        KargP ka = (KargP)__builtin_amdgcn_kernarg_segment_ptr(); asm volatile("" : "+s"(ka));
        const int kind = ka->kind[s], layer = ka->layer[s], sub = ka->sub[s];
        unsigned char* ws = ka->ws; asm volatile("" : "+s"(ws));
        bf16_t* H = (bf16_t*)(ws + OFF_H);
        bf16_t* ACT = (bf16_t*)(ws + OFF_ACT);
        bf16_t* Db = (bf16_t*)(ws + OFF_D);
        bf16_t* Ob = (bf16_t*)(ws + OFF_O);
        bf16_t* KRb = (bf16_t*)(ws + OFF_KR);
        bf16_t* Qb = (bf16_t*)(ws + OFF_Q);
        bf16_t* KVb = (bf16_t*)(ws + OFF_KV);
        bf16_t* XB = (bf16_t*)(ws + OFF_XB);
        float* PARTX = (float*)(ws + OFF_PARTX); float* PARTD = (float*)(ws + OFF_PARTD);
        const float* ctab = (const float*)(ws + OFF_CTAB); const float* stab = (const float*)(ws + OFF_STAB);
        const int j = layer >> 1;
#pragma unroll 1
        for (int rep = 0; rep < ((((PROBE_MASK >> kind) & 1) && (kind != K_GEMM_RESID) && (kind != K_NORM || sub != 2)) ? PROBE_REPS : 1); ++rep) {
        switch (kind) {
        case K_CVT: { Params pl;
            pl.x = ka->x; pl.pos = ka->pos; pl.norm_mix = ka->norm_mix; pl.norm_ffn = ka->norm_ffn; pl.norm_final = ka->norm_final; pl.pool_w = ka->pool_w; pl.pool_scale = ka->pool_scale;
            pl.w_down = ka->w_down; pl.q_norm = ka->q_norm; pl.w_uq = ka->w_uq; pl.kv_norm = ka->kv_norm; pl.w_ukv = ka->w_ukv; pl.w_o = ka->w_o; pl.w_gate = ka->w_gate; pl.w_up = ka->w_up; pl.w_dn = ka->w_dn;
            pl.out = ka->out; pl.ws = ws; pl.ph_lo = 0; pl.ph_hi = 0;
            cvt_phase(pl, smem); __syncthreads(); poolnorm_phase<float>(pl.x, pl.norm_mix, H, nullptr, smem); } break;
        case K_NORM: norm_phase<bf16_t>(XB, ka->norm_final, nullptr, ka->out); break;
        case K_POOLNORM: poolnorm_phase<bf16_t>(XB, ka->norm_mix + layer * 1024, H, PARTX, smem); break;
        case K_ATTN: at::attn_phase(Qb, KVb, KRb, ctab, stab, Ob, (char*)smem); break;
        case K_GEMM_RESID: {
            pg8::Gemm g; pg8::EpiResid E;
            if (sub == 0) { g = pg8::Gemm{H, (const bf16_t*)(ws + OFF_WPOOL) + (size_t)j * 1024 * 256, T, 1024, 256, 1024, 256, 256}; E = pg8::EpiResid{layer == 0 ? ka->x : nullptr, XB, PARTX}; }
            else if (sub == 2) { g = pg8::Gemm{Ob, (const bf16_t*)(ws + OFF_WO) + (size_t)j * 1024 * 1024, T, 1024, 1024, 1024, 1024, 0}; E = pg8::EpiResid{nullptr, XB, PARTX}; }
            else { g = pg8::Gemm{ACT, (const bf16_t*)(ws + OFF_WDN) + (size_t)layer * 1024 * FF, T, 1024, FF, FF, FF, 0}; E = pg8::EpiResid{nullptr, XB, PARTX}; }
            pg8::StaticOrder S; S.init(g.M, g.N, (int)gridDim.x, opq_bid());
            pg8::gemm_phase<pg8::EpiResid>((LAS unsigned char*)smem, g, S, E);
        } break;
        case K_GEMM_MD: {
            pg8::Gemm g{XB, (const bf16_t*)(ws + OFF_WMD) + (size_t)j * 768 * 1024, T, 768, 1024, 1024, 1024, 0};
            pg8::EpiMdown E{Db, KRb, PARTX, PARTD, ctab, stab};
            pg8::StaticOrder S; S.init(g.M, g.N, (int)gridDim.x, opq_bid());
            pg8::gemm_phase<pg8::EpiMdown>((LAS unsigned char*)smem, g, S, E);
        } break;
        case K_GEMM_GU: {
            pg8::Gemm g{XB, (const bf16_t*)(ws + OFF_WGU) + (size_t)layer * 5632 * 1024, T, 5632, 1024, 1024, 1024, 0};
            pg8::EpiSwiglu E{ACT, FF, PARTX, (LAS float*)((LAS unsigned char*)smem + 131072)};
            pg8::StaticOrder S; S.init(g.M, g.N, (int)gridDim.x, opq_bid());
            pg8::gemm_phase<pg8::EpiSwiglu>((LAS unsigned char*)smem, g, S, E);
        } break;
        case K_GEMM_BF16: {
#pragma unroll 1
            for (int w = 0; w < 2; ++w) {
                pg8::Gemm g; pg8::EpiBf16 E;
                if (w == 0) { g = pg8::Gemm{Db, (const bf16_t*)(ws + OFF_WUQ) + (size_t)j * 1536 * 384, T, 1536, 384, 640, 384, 0}; E = pg8::EpiBf16{Qb, 1536, PARTD, 0, 2, 1.0f / 384.0f}; }
                else { g = pg8::Gemm{Db + 384, (const bf16_t*)(ws + OFF_WUKV) + (size_t)j * 2048 * 128, T, 2048, 128, 640, 128, 0}; E = pg8::EpiBf16{KVb, 2048, PARTD, 8, 1, 1.0f / 128.0f}; }
                pg8::StaticOrder S; S.init(g.M, g.N, (int)gridDim.x, opq_bid());
                pg8::gemm_phase<pg8::EpiBf16>((LAS unsigned char*)smem, g, S, E);
            }
        } break;
        default: break;
        }
        if (rep + 1 < ((((PROBE_MASK >> kind) & 1) && (kind != K_GEMM_RESID) && (kind != K_NORM || sub != 2)) ? PROBE_REPS : 1)) GRID_BARRIER();
        }
        if (s + 1 < s_hi) GRID_BARRIER();
    }
}


extern "C" void kernel_launch(void* const* d_in, const int* in_sizes, int n_in, void* d_out, int out_size, void* d_ws, size_t ws_size, hipStream_t stream) {
    static int grid_blocks = 0;
    if (grid_blocks == 0) {
        if (n_in != 16 || in_sizes[0] != T * DM || out_size != T * DM || ws_size < WS_END) {
            fprintf(stderr, "kernel_launch: unexpected shapes (n_in %d, in0 %d, out %d, ws %zu, need %zu)\n", n_in, n_in > 0 ? in_sizes[0] : -1, out_size, ws_size, (size_t)WS_END);
            grid_blocks = -1; return; }
        int dev = 0, cus = 0, per_cu = 0;
        (void)hipGetDevice(&dev);
        if (hipDeviceGetAttribute(&cus, hipDeviceAttributeMultiprocessorCount, dev) != hipSuccess || cus <= 0) cus = 256;
        if (hipFuncSetAttribute((const void*)mega, hipFuncAttributeMaxDynamicSharedMemorySize, LDS_BYTES) != hipSuccess) fprintf(stderr, "kernel_launch: hipFuncSetAttribute failed\n");
        if (hipOccupancyMaxActiveBlocksPerMultiprocessor(&per_cu, (const void*)mega, 512, LDS_BYTES) != hipSuccess || per_cu < 1) { fprintf(stderr, "kernel_launch: occupancy query gave %d\n", per_cu); per_cu = 1; }
        (void)hipGetLastError();
        grid_blocks = cus * per_cu;
    }
    if (grid_blocks < 0) return;
    Params p{};
    p.x = (const float*)d_in[0]; p.pos = (const int*)d_in[1]; p.norm_mix = (const float*)d_in[2]; p.norm_ffn = (const float*)d_in[3]; p.norm_final = (const float*)d_in[4];
    p.pool_w = (const float*)d_in[5]; p.pool_scale = (const float*)d_in[6]; p.w_down = (const float*)d_in[7]; p.q_norm = (const float*)d_in[8]; p.w_uq = (const float*)d_in[9];
    p.kv_norm = (const float*)d_in[10]; p.w_ukv = (const float*)d_in[11]; p.w_o = (const float*)d_in[12]; p.w_gate = (const float*)d_in[13]; p.w_up = (const float*)d_in[14]; p.w_dn = (const float*)d_in[15];
    p.out = (float*)d_out; p.ws = (unsigned char*)d_ws;
    { int n = 0;
#define ADD(k, l, sb) do { p.kind[n] = (unsigned char)(k); p.layer[n] = (unsigned char)(l); p.sub[n] = (unsigned char)(sb); ++n; } while (0)
      ADD(K_CVT, 0, 0);
      for (int l = 0; l < 4; ++l) {
          if ((l & 1) == 0) { if (l > 0) ADD(K_POOLNORM, l, 0); ADD(K_GEMM_RESID, l, 0); }
          else { ADD(K_GEMM_MD, l, 0); ADD(K_GEMM_BF16, l, 0); ADD(K_ATTN, l, 0); ADD(K_GEMM_RESID, l, 2); }
          ADD(K_GEMM_GU, l, 0); ADD(K_GEMM_RESID, l, 3);
      }
      ADD(K_NORM, 0, 2);
#undef ADD
      if (n != NSTEPS) fprintf(stderr, "kernel_launch: step program has %d steps, expected %d\n", n, NSTEPS); }
#if MK_SINGLE
    p.ph_lo = 0; p.ph_hi = NSTEPS;
    (void)hipMemsetAsync((char*)d_ws + OFF_BAR, 0, 16384, stream);
    void* args[] = {&p};
    hipError_t e = hipLaunchCooperativeKernel((const void*)mega, dim3(grid_blocks), dim3(512), args, LDS_BYTES, stream);
    if (e != hipSuccess) fprintf(stderr, "cooperative launch failed: %s (grid %d)\n", hipGetErrorString(e), grid_blocks);
#else
    for (int s = 0; s < NRUN; ++s) {
        p.ph_lo = s; p.ph_hi = s + 1;
        hipLaunchKernelGGL(mega, dim3(grid_blocks), dim3(512), LDS_BYTES, stream, p);
    }
#endif
}
```

```cpp
#include <hip/hip_runtime.h>
#include <hip/hip_cooperative_groups.h>
#include <cstdio>
#include <cstdint>
namespace cg = cooperative_groups;

#ifndef MK_SINGLE
#define MK_SINGLE 1
#endif
#ifndef PROBE_MASK
#define PROBE_MASK 0
#define PROBE_REPS 2
#endif
#ifndef MK_DEBUG
#define MK_DEBUG 0
#endif
#ifndef DBG_IGNORE
#define DBG_IGNORE 0ull
#endif


typedef unsigned short bf16_t;
typedef short bf16x8 __attribute__((ext_vector_type(8)));
typedef short s16x4 __attribute__((ext_vector_type(4)));
typedef float f32x4 __attribute__((ext_vector_type(4)));
typedef float f32x16 __attribute__((ext_vector_type(16)));
typedef unsigned u32x4 __attribute__((ext_vector_type(4)));
typedef unsigned u32x2 __attribute__((ext_vector_type(2)));
#define LAS __attribute__((address_space(3)))

constexpr int T = 32768, DM = 1024, SEQ = 4096, FF = 2816;
constexpr float EPS = 1e-6f;

constexpr size_t OFF_WPOOL = 0;
constexpr size_t OFF_WMD   = OFF_WPOOL + (size_t)2 * 1024 * 256 * 2;
constexpr size_t OFF_WUQ   = OFF_WMD + (size_t)2 * 768 * 1024 * 2;
constexpr size_t OFF_WUKV  = OFF_WUQ + (size_t)2 * 1536 * 384 * 2;
constexpr size_t OFF_WO    = OFF_WUKV + (size_t)2 * 2048 * 256 * 2;
constexpr size_t OFF_WGU   = OFF_WO + (size_t)2 * 1024 * 1024 * 2;
constexpr size_t OFF_WDN   = OFF_WGU + (size_t)4 * 5632 * 1024 * 2;
constexpr size_t OFF_CTAB  = OFF_WDN + (size_t)4 * 1024 * 2816 * 2;
constexpr size_t OFF_STAB  = OFF_CTAB + (size_t)T * 32 * 4;
constexpr size_t OFF_H     = OFF_STAB + (size_t)T * 32 * 4;
constexpr size_t OFF_BIG   = OFF_H + (size_t)T * 1024 * 2;
constexpr size_t OFF_ACT   = OFF_BIG;
constexpr size_t OFF_D     = OFF_BIG;
constexpr size_t OFF_O     = OFF_BIG;
constexpr size_t OFF_KR    = OFF_BIG + (size_t)T * 1024 * 2;
constexpr size_t OFF_Q     = OFF_KR + (size_t)T * 64 * 2;
constexpr size_t OFF_KV    = OFF_Q + (size_t)T * 1536 * 2;

constexpr size_t OFF_PARTX = OFF_KV + (size_t)T * 2048 * 2;
constexpr size_t OFF_PARTD = OFF_PARTX + (size_t)T * 16 * 4;
constexpr size_t OFF_BAR   = OFF_PARTD + (size_t)T * 16 * 4;
constexpr size_t OFF_XB    = OFF_BAR + 16384;
constexpr size_t WS_END    = OFF_XB + (size_t)T * 1024 * 2;
static_assert(WS_END <= (size_t)536870912, "workspace");

constexpr int LDS_BYTES = 133120 + 64;

struct Params {
    const float* x; const int* pos; const float* norm_mix; const float* norm_ffn; const float* norm_final;
    const float* pool_w; const float* pool_scale; const float* w_down; const float* q_norm; const float* w_uq;
    const float* kv_norm; const float* w_ukv; const float* w_o; const float* w_gate; const float* w_up; const float* w_dn;
    float* out; unsigned char* ws; int ph_lo, ph_hi;
    unsigned char kind[32], layer[32], sub[32];
};

__device__ __forceinline__ unsigned cvtpk(float lo, float hi) {
    unsigned r; asm volatile("v_cvt_pk_bf16_f32 %0, %1, %2" : "=v"(r) : "v"(lo), "v"(hi)); return r;
}
__device__ __forceinline__ float bf2f(short v) { return __uint_as_float(((unsigned)(unsigned short)v) << 16); }
__device__ __forceinline__ bf16x8 pack8(f32x4 a, f32x4 b) {
    u32x4 w = {cvtpk(a[0], a[1]), cvtpk(a[2], a[3]), cvtpk(b[0], b[1]), cvtpk(b[2], b[3])};
    return *reinterpret_cast<bf16x8*>(&w);
}
__device__ __forceinline__ f32x4 ld4(const float* p) { return *(const f32x4*)p; }
__device__ __forceinline__ f32x4 ld4(const bf16_t* p) { const u32x2 w = *(const u32x2*)p; return f32x4{__uint_as_float(w.x << 16), __uint_as_float(w.x & 0xffff0000u), __uint_as_float(w.y << 16), __uint_as_float(w.y & 0xffff0000u)}; }
__device__ __forceinline__ float2 ld2(const float* p) { return *(const float2*)p; }
__device__ __forceinline__ float2 ld2(const bf16_t* p) { const unsigned w = *(const unsigned*)p; return make_float2(__uint_as_float(w << 16), __uint_as_float(w & 0xffff0000u)); }
__device__ __forceinline__ int opq_tid() { int t = threadIdx.x; asm volatile("" : "+v"(t)); return t; }
__device__ __forceinline__ int opq_bid() { int b = blockIdx.x; asm volatile("" : "+s"(b)); return b; }
__device__ __forceinline__ float wave_sum(float v) {
#pragma unroll
    for (int off = 32; off >= 1; off >>= 1) v += __shfl_xor(v, off);
    return v;
}

namespace pg8 {
constexpr int BM = 256, BK = 64, HALF = 128, HTB = HALF * BK * 2, NXCD = 8, WGM = 8;
__device__ __forceinline__ int lds_byte(int r, int c) { const int st = (r >> 4) * 2 + (c >> 5), rr = r & 15, cc = c & 31, ob = rr * 64 + cc * 2; return st * 1024 + (ob ^ (((ob >> 9) & 1) << 5)); }
__device__ __forceinline__ void stage_rc(int b, int& R, int& C) { const int st = b / 1024, sb = b % 1024, swz = sb ^ (((sb >> 9) & 1) << 5); R = (st >> 1) * 16 + swz / 64; C = (st & 1) * 32 + (swz % 64) / 2; }
__device__ __forceinline__ int perm32(int rho) { const int n = rho >> 4, i = rho & 15; return 8 * (i >> 2) + 4 * n + (i & 3); }
struct Unit { int pm, pn; };
struct Gemm { const bf16_t* A; const bf16_t* Bt; int M, N, K, lda, ldb, a_pn_off; };
struct StaticOrder {
    int nM, nN, nwg, G, c;
    __device__ void init(int M, int N, int G_, int c_) { nM = M / BM; nN = N / BM; nwg = nM * nN; G = G_; c = c_; }
    __device__ bool next(int i, Unit& u) const {
        const long L = (long)i * G + c; if (L >= nwg) return false;
        int wgid = (int)L; { const int q = nwg / NXCD, r = nwg % NXCD, xcd = wgid % NXCD, off = wgid / NXCD; wgid = (xcd < r ? xcd * (q + 1) : r * (q + 1) + (xcd - r) * q) + off; }
        const int nig = WGM * nN, gid = wgid / nig, fm = gid * WGM, gsz = (nM - fm) < WGM ? (nM - fm) : WGM;
        u.pm = fm + ((wgid % nig) % gsz); u.pn = (wgid % nig) / gsz; return true;
    }
};
__device__ __forceinline__ void rows_rstd(float (&rstd)[2][4], const float* part, int row0, int s0, int nq4, float invn, int fq) {
    f32x4 t[2][4]; const int q = fq < nq4 ? fq : nq4 - 1;
#pragma unroll
    for (int ai = 0; ai < 2; ++ai)
#pragma unroll
        for (int m = 0; m < 4; ++m) t[ai][m] = *(const f32x4*)(part + (size_t)(row0 + ai * HALF + m * 16) * 16 + s0 + q * 4);
#pragma unroll
    for (int ai = 0; ai < 2; ++ai)
#pragma unroll
        for (int m = 0; m < 4; ++m) { float ss = (t[ai][m][0] + t[ai][m][1]) + (t[ai][m][2] + t[ai][m][3]); ss = fq < nq4 ? ss : 0.f;
            ss += __shfl_xor(ss, 16); ss += __shfl_xor(ss, 32); rstd[ai][m] = rsqrtf(ss * invn + EPS); }
}
struct EpiResid {
    static constexpr bool PERM = false;
    const float* Rf; bf16_t* XB; float* PART;
    typedef int State;
    __device__ __forceinline__ void row_out(const f32x4 (&acc)[2][2][4][2], const f32x4 (&rv)[2][2], int ai, int m, int row, int col0, int slot, int fq) const {
        const size_t ro = (size_t)row * 1024 + col0; float ss = 0.f;
#pragma unroll
        for (int bj = 0; bj < 2; ++bj)
#pragma unroll
            for (int n = 0; n < 2; ++n) { const int cofs = bj * HALF + n * 16;
                const f32x4 v = acc[ai][bj][m][n] + rv[bj][n];
                ss += (v[0] * v[0] + v[1] * v[1]) + (v[2] * v[2] + v[3] * v[3]);
                u32x2 w = {cvtpk(v[0], v[1]), cvtpk(v[2], v[3])}; *(u32x2*)(XB + ro + cofs) = w; }
        ss += __shfl_xor(ss, 16); ss += __shfl_xor(ss, 32);
        if (fq == 0) PART[(size_t)row * 16 + slot] = ss;
    }
    __device__ __forceinline__ void operator()(const f32x4 (&acc)[2][2][4][2], const Unit& u, int wr, int wc, int fr, int fq, State&) const {
        const int row0 = u.pm * BM + wr * 64 + fr, col0 = u.pn * BM + wc * 32 + 4 * fq, slot = u.pn * 4 + wc;
        if (Rf) {
#pragma unroll
            for (int ai = 0; ai < 2; ++ai)
#pragma unroll
                for (int mp = 0; mp < 2; ++mp) { f32x4 rv[2][2][2];
#pragma unroll
                    for (int mm = 0; mm < 2; ++mm)
#pragma unroll
                        for (int bj = 0; bj < 2; ++bj)
#pragma unroll
                            for (int n = 0; n < 2; ++n) rv[mm][bj][n] = ld4(Rf + (size_t)(row0 + ai * HALF + (mp * 2 + mm) * 16) * 1024 + col0 + bj * HALF + n * 16);
#pragma unroll
                    for (int mm = 0; mm < 2; ++mm) row_out(acc, rv[mm], ai, mp * 2 + mm, row0 + ai * HALF + (mp * 2 + mm) * 16, col0, slot, fq); }
        } else {
#pragma unroll
            for (int ai = 0; ai < 2; ++ai) { u32x2 rw[4][2][2];
#pragma unroll
                for (int m = 0; m < 4; ++m)
#pragma unroll
                    for (int bj = 0; bj < 2; ++bj)
#pragma unroll
                        for (int n = 0; n < 2; ++n) rw[m][bj][n] = *(const u32x2*)(XB + (size_t)(row0 + ai * HALF + m * 16) * 1024 + col0 + bj * HALF + n * 16);
#pragma unroll
                for (int m = 0; m < 4; ++m) { f32x4 rv[2][2];
#pragma unroll
                    for (int bj = 0; bj < 2; ++bj)
#pragma unroll
                        for (int n = 0; n < 2; ++n) { const u32x2 w = rw[m][bj][n]; rv[bj][n] = f32x4{__uint_as_float(w.x << 16), __uint_as_float(w.x & 0xffff0000u), __uint_as_float(w.y << 16), __uint_as_float(w.y & 0xffff0000u)}; }
                    row_out(acc, rv, ai, m, row0 + ai * HALF + m * 16, col0, slot, fq); } }
        }
    }
};
struct EpiMdown {
    static constexpr bool PERM = false;
    bf16_t* D; bf16_t* KR; const float* PARTX; float* PARTD; const float* ctab; const float* stab;
    typedef int State;
    __device__ __forceinline__ void operator()(const f32x4 (&acc)[2][2][4][2], const Unit& u, int wr, int wc, int fr, int fq, State&) const {
        const int row0 = u.pm * BM + wr * 64 + fr, col0 = u.pn * BM + wc * 32 + 4 * fq;
        float rs[2][4]; rows_rstd(rs, PARTX, row0, 0, 4, 1.0f / 1024.0f, fq);
        const bool rope = (u.pn == 2) && (wc < 2); const int ri = wc * 16 + 4 * fq;
#pragma unroll
        for (int ai = 0; ai < 2; ++ai) {
            f32x4 csv[4], snv[4];
            if (rope) {
#pragma unroll
                for (int m = 0; m < 4; ++m) { const size_t to = (size_t)(row0 + ai * HALF + m * 16) * 32 + ri; csv[m] = *(const f32x4*)(ctab + to); snv[m] = *(const f32x4*)(stab + to); } }
#pragma unroll
            for (int m = 0; m < 4; ++m) { const int row = row0 + ai * HALF + m * 16; const float rstd = rs[ai][m];
                float s0 = 0.f, s1 = 0.f; f32x4 vv[2][2];
#pragma unroll
                for (int bj = 0; bj < 2; ++bj)
#pragma unroll
                    for (int n = 0; n < 2; ++n) { const int c = col0 + bj * HALF + n * 16; const f32x4 v = acc[ai][bj][m][n] * rstd; vv[bj][n] = v;
                        if (c < 640) { u32x2 w = {cvtpk(v[0], v[1]), cvtpk(v[2], v[3])}; *(u32x2*)(D + (size_t)row * 640 + c) = w; }
                        const float q = (v[0] * v[0] + v[1] * v[1]) + (v[2] * v[2] + v[3] * v[3]);
                        if (bj == 0) s0 += q; else s1 += q; }
                s0 += __shfl_xor(s0, 16); s0 += __shfl_xor(s0, 32); s1 += __shfl_xor(s1, 16); s1 += __shfl_xor(s1, 32);
                if (u.pn == 0) { if (fq == 0) PARTD[(size_t)row * 16 + wc] = s0 + s1; }
                else if (u.pn == 1) { if (fq == 0) { PARTD[(size_t)row * 16 + 4 + wc] = s0; PARTD[(size_t)row * 16 + 8 + wc] = s1; } }
                else if (rope) {
                    const int i = ri; const f32x4 cs = csv[m], sn = snv[m];
                    const f32x4 x1 = vv[0][0], x2 = vv[0][1]; const f32x4 y1 = x1 * cs - x2 * sn, y2 = x2 * cs + x1 * sn;
                    u32x2 w1 = {cvtpk(y1[0], y1[1]), cvtpk(y1[2], y1[3])}, w2 = {cvtpk(y2[0], y2[1]), cvtpk(y2[2], y2[3])};
                    *(u32x2*)(KR + (size_t)row * 64 + i) = w1; *(u32x2*)(KR + (size_t)row * 64 + 32 + i) = w2; } } }
    }
};
struct EpiBf16 {
    static constexpr bool PERM = true;
    bf16_t* O; int ldc; const float* PART; int s0, nq4; float invn;
    typedef int State;
    __device__ __forceinline__ void operator()(const f32x4 (&acc)[2][2][4][2], const Unit& u, int wr, int wc, int fr, int fq, State&) const {
        const int row0 = u.pm * BM + wr * 64 + fr, col0 = u.pn * BM + wc * 32 + 8 * fq;
        float rs[2][4]; rows_rstd(rs, PART, row0, s0, nq4, invn, fq);
#pragma unroll
        for (int ai = 0; ai < 2; ++ai)
#pragma unroll
            for (int m = 0; m < 4; ++m) { const int row = row0 + ai * HALF + m * 16; const float rstd = rs[ai][m];
                bf16_t* rowp = O + (size_t)row * ldc + col0;
#pragma unroll
                for (int bj = 0; bj < 2; ++bj) { const f32x4 v0 = acc[ai][bj][m][0] * rstd, v1 = acc[ai][bj][m][1] * rstd;
                    u32x4 w; w.x = cvtpk(v0[0], v0[1]); w.y = cvtpk(v0[2], v0[3]); w.z = cvtpk(v1[0], v1[1]); w.w = cvtpk(v1[2], v1[3]);
                    *(u32x4*)(rowp + bj * HALF) = w; } }
    }
};
__device__ __forceinline__ f32x4 silu_mul4(f32x4 g, f32x4 u) {
    const f32x4 t = g * (-1.4426950408889634f); f32x4 e;
#pragma unroll
    for (int i = 0; i < 4; ++i) e[i] = __builtin_amdgcn_exp2f(t[i]);
    const f32x4 d = e + 1.0f; f32x4 r;
#pragma unroll
    for (int i = 0; i < 4; ++i) r[i] = __builtin_amdgcn_rcpf(d[i]);
    return (g * u) * r;
}
struct EpiSwiglu {
    static constexpr bool PERM = true;
    bf16_t* O; int ldc; const float* PARTX; LAS float* rc;
    typedef int State;
    __device__ __forceinline__ void operator()(const f32x4 (&acc)[2][2][4][2], const Unit& u, int wr, int wc, int fr, int fq, State& st) const {
        const int row0 = u.pm * BM + wr * 64 + fr, col0 = u.pn * HALF + wc * 32 + 8 * fq;
        float rs[2][4];
        if (st != u.pm) { rows_rstd(rs, PARTX, row0, 0, 4, 1.0f / 1024.0f, fq); st = u.pm;
#pragma unroll
            for (int ai = 0; ai < 2; ++ai)
#pragma unroll
                for (int m = 0; m < 4; ++m) rc[wr * 64 + ai * HALF + m * 16 + fr] = rs[ai][m]; }
        else {
#pragma unroll
            for (int ai = 0; ai < 2; ++ai)
#pragma unroll
                for (int m = 0; m < 4; ++m) rs[ai][m] = rc[wr * 64 + ai * HALF + m * 16 + fr]; }
#pragma unroll
        for (int ai = 0; ai < 2; ++ai)
#pragma unroll
            for (int m = 0; m < 4; ++m) { const int row = row0 + ai * HALF + m * 16; const float rstd = rs[ai][m];
                bf16_t* rowp = O + (size_t)row * ldc + col0;
                const f32x4 a0 = silu_mul4(acc[ai][0][m][0] * rstd, acc[ai][1][m][0] * rstd), a1 = silu_mul4(acc[ai][0][m][1] * rstd, acc[ai][1][m][1] * rstd);
                u32x4 w; w.x = cvtpk(a0[0], a0[1]); w.y = cvtpk(a0[2], a0[3]); w.z = cvtpk(a1[0], a1[1]); w.w = cvtpk(a1[2], a1[3]);
                *(u32x4*)rowp = w; }
    }
};

template <class Epi>
__device__ __forceinline__ void gemm_phase(LAS unsigned char* lds, const Gemm g, const StaticOrder& S, const Epi& E) {
    const int tid = opq_tid(), wid = __builtin_amdgcn_readfirstlane(tid >> 6), lane = tid & 63, wr = wid >> 2, wc = wid & 3, fr = lane & 15, fq = lane >> 4;
    const int K = g.K, nt = K / BK;
    unsigned voffA[2], voffB[2];
#pragma unroll
    for (int i = 0; i < 2; ++i) { int R, C; stage_rc(tid * 16 + i * 8192, R, C); const int Rb = Epi::PERM ? ((R & ~31) + perm32(R & 31)) : R;
        voffA[i] = (unsigned)(R * g.lda + C) * 2u; voffB[i] = (unsigned)(Rb * g.ldb + C) * 2u; }
    const size_t kstep = (size_t)(BK * 2);
    const size_t hstepA = (size_t)HALF * g.lda * 2, hstepB = (size_t)HALF * g.ldb * 2;
    const size_t tstepA = 2 * hstepA, tstepB = 2 * hstepB;
    const size_t pnA = (size_t)g.a_pn_off * 2;
    const unsigned ldsw = (unsigned)wid * 1024u;
    const int aoff = lds_byte(wr * 64 + fr, fq * 8), boff = lds_byte(wc * 32 + fr, fq * 8);
#define PG8_SA(b, h) (((b) * 2 + (h)) * HTB)
#define PG8_SB(b, h) ((4 + (b) * 2 + (h)) * HTB)
#define PG8_STAGE(bufoff, gbase, voff) do { _Pragma("unroll") for (int _i = 0; _i < 2; ++_i) \
        __builtin_amdgcn_global_load_lds((const unsigned*)((const char*)(gbase) + (voff)[_i]), (LAS unsigned*)(lds + (bufoff) + ldsw + _i * 8192), 16, 0, 0); } while (0)
#define PG8_LDA(dst, b, h) do { _Pragma("unroll") for (int m = 0; m < 4; ++m) _Pragma("unroll") for (int k = 0; k < 2; ++k) dst[m][k] = *(const LAS bf16x8*)(lds + PG8_SA(b, h) + aoff + m * 2048 + k * 1024); } while (0)
#define PG8_LDB(dst, b, h) do { _Pragma("unroll") for (int n = 0; n < 2; ++n) _Pragma("unroll") for (int k = 0; k < 2; ++k) dst[n][k] = *(const LAS bf16x8*)(lds + PG8_SB(b, h) + boff + n * 2048 + k * 1024); } while (0)
#define PG8_MMA(ai, bj, At, Bt) do { __builtin_amdgcn_s_setprio(1); _Pragma("unroll") for (int m = 0; m < 4; ++m) _Pragma("unroll") for (int n = 0; n < 2; ++n) _Pragma("unroll") for (int k = 0; k < 2; ++k) \
        acc[ai][bj][m][n] = __builtin_amdgcn_mfma_f32_16x16x32_bf16(Bt[n][k], At[m][k], acc[ai][bj][m][n], 0, 0, 0); __builtin_amdgcn_s_setprio(0); } while (0)
#define PG8_WAIT_V(n) asm volatile("s_waitcnt vmcnt(" #n ")" ::: "memory")
#define PG8_WAIT_L(n) asm volatile("s_waitcnt lgkmcnt(" #n ")" ::: "memory")
#define PG8_BAR __builtin_amdgcn_s_barrier()
#define PG8_SCHED __builtin_amdgcn_sched_barrier(0)
    Unit cur, nxt; int ui = 0;
    if (!S.next(0, cur)) return;
    typename Epi::State est; *(int*)&est = -1;
    f32x4 acc[2][2][4][2];
#pragma unroll
    for (int a = 0; a < 2; ++a)
#pragma unroll
        for (int b = 0; b < 2; ++b)
#pragma unroll
            for (int m = 0; m < 4; ++m)
#pragma unroll
                for (int n = 0; n < 2; ++n) acc[a][b][m][n] = (f32x4){0.f, 0.f, 0.f, 0.f};
    bf16x8 At[4][2], B0[2][2], B1[2][2];
    const char* cA = (const char*)g.A + (size_t)cur.pm * tstepA + (size_t)cur.pn * pnA; const char* cB = (const char*)g.Bt + (size_t)cur.pn * tstepB;
    PG8_STAGE(PG8_SB(0, 0), cB, voffB); PG8_STAGE(PG8_SA(0, 0), cA, voffA); PG8_STAGE(PG8_SB(0, 1), cB + hstepB, voffB); PG8_STAGE(PG8_SA(0, 1), cA + hstepA, voffA);
    if (wr == 1) PG8_BAR;
    PG8_WAIT_V(4); PG8_BAR;
    PG8_STAGE(PG8_SB(1, 0), cB + kstep, voffB); PG8_STAGE(PG8_SA(1, 0), cA + kstep, voffA); PG8_STAGE(PG8_SB(1, 1), cB + hstepB + kstep, voffB);
    PG8_WAIT_V(6); PG8_BAR;
    for (;;) {
        const bool has_next = S.next(ui + 1, nxt);
        const char* nA = has_next ? (const char*)g.A + (size_t)nxt.pm * tstepA + (size_t)nxt.pn * pnA : cA; const char* nB = has_next ? (const char*)g.Bt + (size_t)nxt.pn * tstepB : cB;
        for (int t = 0; t < nt; t += 2) {
            const bool last = (t == nt - 2);
            const char* a1 = cA + (size_t)(t + 1) * kstep;
            const char* a2 = last ? nA : cA + (size_t)(t + 2) * kstep; const char* b2 = last ? nB : cB + (size_t)(t + 2) * kstep;
            const char* a3 = a2 + kstep; const char* b3 = b2 + kstep;
            PG8_LDB(B0, 0, 0); PG8_SCHED; PG8_LDA(At, 0, 0); PG8_STAGE(PG8_SA(1, 1), a1 + hstepA, voffA);
            PG8_WAIT_L(8); PG8_BAR; PG8_WAIT_L(0); PG8_MMA(0, 0, At, B0); PG8_BAR; PG8_SCHED;
            PG8_LDB(B1, 0, 1); PG8_STAGE(PG8_SB(0, 0), b2, voffB);
            PG8_BAR; PG8_WAIT_L(0); PG8_MMA(0, 1, At, B1); PG8_BAR;
            PG8_LDA(At, 0, 1); PG8_STAGE(PG8_SA(0, 0), a2, voffA);
            PG8_BAR; PG8_WAIT_L(0); PG8_MMA(1, 0, At, B0); PG8_BAR; PG8_SCHED;
            PG8_STAGE(PG8_SB(0, 1), b2 + hstepB, voffB);
            PG8_WAIT_V(6); PG8_BAR; PG8_MMA(1, 1, At, B1); PG8_BAR;
            PG8_LDB(B0, 1, 0); PG8_SCHED; PG8_LDA(At, 1, 0); PG8_STAGE(PG8_SA(0, 1), a2 + hstepA, voffA);
            PG8_WAIT_L(8); PG8_BAR; PG8_WAIT_L(0); PG8_MMA(0, 0, At, B0); PG8_BAR; PG8_SCHED;
            PG8_LDB(B1, 1, 1); PG8_STAGE(PG8_SB(1, 0), b3, voffB);
            PG8_BAR; PG8_WAIT_L(0); PG8_MMA(0, 1, At, B1); PG8_BAR;
            PG8_LDA(At, 1, 1); PG8_STAGE(PG8_SA(1, 0), a3, voffA);
            PG8_BAR; PG8_WAIT_L(0); PG8_MMA(1, 0, At, B0); PG8_BAR; PG8_SCHED;
            PG8_STAGE(PG8_SB(1, 1), b3 + hstepB, voffB);
            PG8_WAIT_V(6); PG8_BAR; PG8_MMA(1, 1, At, B1); PG8_BAR;
        }
        E(acc, cur, wr, wc, fr, fq, est);
        if (!has_next) break;
#pragma unroll
        for (int a = 0; a < 2; ++a)
#pragma unroll
            for (int b = 0; b < 2; ++b)
#pragma unroll
                for (int m = 0; m < 4; ++m)
#pragma unroll
                    for (int n = 0; n < 2; ++n) acc[a][b][m][n] = (f32x4){0.f, 0.f, 0.f, 0.f};
        cur = nxt; cA = nA; cB = nB; ++ui;
    }
    PG8_WAIT_V(0);
    if (wr == 0) PG8_BAR;
    PG8_BAR;
#undef PG8_SA
#undef PG8_SB
#undef PG8_STAGE
#undef PG8_LDA
#undef PG8_LDB
#undef PG8_MMA
#undef PG8_WAIT_V
#undef PG8_WAIT_L
#undef PG8_BAR
#undef PG8_SCHED
}
}

namespace at {
constexpr float SCALE = 0.07216878364870322f;
constexpr float THR = 8.f;
constexpr int SHM_V = 16384, SHM_K = 16384, SHM_KR = 8192;
#define KSWZ(row, colB) ((row) * 256 + ((colB) ^ (((row) & 7) << 4)))
#define SBAR() __builtin_amdgcn_sched_barrier(0)
__device__ __forceinline__ int v_st(int k, int c) { const int kk = (k & ~0xC) | ((k & 4) << 1) | ((k & 8) >> 1); return ((kk >> 3) * 4 + (c >> 5)) * 512 + ((kk & 7) * 32 + (c & 31)) * 2; }
__device__ __forceinline__ int v_rd_base(int lane) { return ((lane & 3) << 3) | (((lane >> 2) & 3) << 6) | (((lane >> 4) & 1) << 5) | (((lane >> 5) & 1) << 8); }
constexpr int v_rd_off(int d0, int ks, int half) { return d0 * 512 + ks * 4096 + half * 2048; }
__device__ __forceinline__ int crow(int r, int hi) { return (r & 3) + 8 * (r >> 2) + 4 * hi; }
__device__ __forceinline__ void mask_tile(f32x16& p0, f32x16& p1, int dq, unsigned W) {
    const float NEG = -__builtin_inff();
#pragma unroll
    for (int r = 0; r < 16; ++r) {
        const int c = (r & 3) + 8 * (r >> 2);
        if ((unsigned)(dq - c) >= W) p0[r] = NEG;
        if ((unsigned)(dq - c - 32) >= W) p1[r] = NEG;
    }
}
__device__ __forceinline__ void partialSM(f32x16& p0, f32x16& p1, float& m_reg, float& mn, float& alpha) {
    float pmax = p0[0];
#pragma unroll
    for (int r = 1; r < 16; ++r) pmax = fmaxf(pmax, p0[r]);
#pragma unroll
    for (int r = 0; r < 16; ++r) pmax = fmaxf(pmax, p1[r]);
    { auto rr = __builtin_amdgcn_permlane32_swap(__float_as_uint(pmax), __float_as_uint(pmax), false, false);
      pmax = fmaxf(__uint_as_float(rr[0]), __uint_as_float(rr[1])); }
    constexpr float C2 = 1.4426950408889634f * SCALE;
    if (__builtin_expect(__all((pmax - m_reg) * SCALE <= THR), 1)) { mn = m_reg; alpha = 1.f; }
    else { mn = fmaxf(m_reg, pmax); alpha = __builtin_amdgcn_exp2f((m_reg - mn) * C2); m_reg = mn; }
    const float mnL = -mn * C2;
#pragma unroll
    for (int r = 0; r < 16; ++r) p0[r] = fmaf(p0[r], C2, mnL);
#pragma unroll
    for (int r = 0; r < 16; ++r) p1[r] = fmaf(p1[r], C2, mnL);
#pragma unroll
    for (int r = 0; r < 16; ++r) p0[r] = __builtin_amdgcn_exp2f(p0[r]);
}
__device__ __forceinline__ void finishSM(f32x16& p0, f32x16& p1, float alpha, float& l_reg, bf16x8& pa0, bf16x8& pa1, bf16x8& pa2, bf16x8& pa3) {
#pragma unroll
    for (int r = 0; r < 16; ++r) p1[r] = __builtin_amdgcn_exp2f(p1[r]);
    float ps = 0;
#pragma unroll
    for (int r = 0; r < 16; ++r) ps += p0[r];
#pragma unroll
    for (int r = 0; r < 16; ++r) ps += p1[r];
    { auto rr = __builtin_amdgcn_permlane32_swap(__float_as_uint(ps), __float_as_uint(ps), false, false);
      ps = __uint_as_float(rr[0]) + __uint_as_float(rr[1]); }
    l_reg = l_reg * alpha + ps;
#define PK4(P, B_, OUT) do { unsigned a0 = cvtpk(P[B_+0], P[B_+1]), a1 = cvtpk(P[B_+2], P[B_+3]);                          \
        unsigned b0 = cvtpk(P[B_+4], P[B_+5]), b1 = cvtpk(P[B_+6], P[B_+7]);                                             \
        auto r0 = __builtin_amdgcn_permlane32_swap(a0, b0, false, false); auto r1 = __builtin_amdgcn_permlane32_swap(a1, b1, false, false); \
        u32x4 w = {r0[0], r1[0], r0[1], r1[1]}; OUT = *reinterpret_cast<bf16x8*>(&w); } while (0)
    PK4(p0, 0, pa0); PK4(p0, 8, pa1); PK4(p1, 0, pa2); PK4(p1, 8, pa3);
#undef PK4
}
__device__ __forceinline__ void qkt(f32x16& p0, f32x16& p1, const char* K_lds, const char* KR_lds, const char* QR_l, int r32, int hi, const bf16x8* qr) {
    p0 = f32x16{}; p1 = f32x16{};
    const char* kb[4];
#pragma unroll
    for (int dd = 0; dd < 4; ++dd) kb[dd] = K_lds + KSWZ(r32, (dd * 16 + hi * 8) * 2);
#pragma unroll
    for (int d0 = 0; d0 < 8; ++d0) { const char* a = kb[d0 & 3] + (d0 >> 2) * 128;
        bf16x8 b0 = *reinterpret_cast<const bf16x8*>(a);
        bf16x8 b1 = *reinterpret_cast<const bf16x8*>(a + 32 * 256);
        p0 = __builtin_amdgcn_mfma_f32_32x32x16_bf16(b0, qr[d0], p0, 0, 0, 0);
        p1 = __builtin_amdgcn_mfma_f32_32x32x16_bf16(b1, qr[d0], p1, 0, 0, 0); }
#pragma unroll
    for (int d1 = 0; d1 < 4; ++d1) { const char* a = KR_lds + r32 * 128 + (((d1 * 16 + hi * 8) * 2) ^ ((r32 & 7) << 4));
        bf16x8 b0 = *reinterpret_cast<const bf16x8*>(a);
        bf16x8 b1 = *reinterpret_cast<const bf16x8*>(a + 32 * 128);
        const bf16x8 qv = *reinterpret_cast<const bf16x8*>(QR_l + d1 * 1024);
        p0 = __builtin_amdgcn_mfma_f32_32x32x16_bf16(b0, qv, p0, 0, 0, 0);
        p1 = __builtin_amdgcn_mfma_f32_32x32x16_bf16(b1, qv, p1, 0, 0, 0); }
}
__device__ __forceinline__ void pv_tile(f32x16* o, int vb0, bf16x8 pa0, bf16x8 pa1, bf16x8 pa2, bf16x8 pa3) {
#define TRRD(dst, off) asm volatile("ds_read_b64_tr_b16 %0, %1 offset:%2" : "=&v"(dst) : "v"(vb0), "i"(off) : "memory")
#define PV_D0(d0) do { s16x4 l0, l1, l2, l3, h0, h1, h2, h3; constexpr int b_ = v_rd_off(d0, 0, 0); \
        TRRD(l0, b_); TRRD(h0, b_ + 2048); TRRD(l1, b_ + 4096); TRRD(h1, b_ + 6144); TRRD(l2, b_ + 8192); TRRD(h2, b_ + 10240); TRRD(l3, b_ + 12288); TRRD(h3, b_ + 14336); \
        asm volatile("s_waitcnt lgkmcnt(0)" ::: "memory"); SBAR();   \
        o[d0] = __builtin_amdgcn_mfma_f32_32x32x16_bf16(pa0, (bf16x8){l0[0], l0[1], l0[2], l0[3], h0[0], h0[1], h0[2], h0[3]}, o[d0], 0, 0, 0);   \
        o[d0] = __builtin_amdgcn_mfma_f32_32x32x16_bf16(pa1, (bf16x8){l1[0], l1[1], l1[2], l1[3], h1[0], h1[1], h1[2], h1[3]}, o[d0], 0, 0, 0);   \
        o[d0] = __builtin_amdgcn_mfma_f32_32x32x16_bf16(pa2, (bf16x8){l2[0], l2[1], l2[2], l2[3], h2[0], h2[1], h2[2], h2[3]}, o[d0], 0, 0, 0);   \
        o[d0] = __builtin_amdgcn_mfma_f32_32x32x16_bf16(pa3, (bf16x8){l3[0], l3[1], l3[2], l3[3], h3[0], h3[1], h3[2], h3[3]}, o[d0], 0, 0, 0); } while (0)
    PV_D0(0); PV_D0(1); PV_D0(2); PV_D0(3);
#undef PV_D0
#undef TRRD
}

__device__ __forceinline__ void attn_qblock(const bf16_t* __restrict__ Q, const bf16_t* __restrict__ KV, const bf16_t* __restrict__ KR,
                                            const float* __restrict__ ctab, const float* __restrict__ stab, bf16_t* __restrict__ O,
                                            int b, int h, int qb, char* lds) {
    const int tid = opq_tid(), wid = __builtin_amdgcn_readfirstlane(tid >> 6), lane = tid & 63, r32 = lane & 31, hi = lane >> 5;
    const int P0 = qb * 256, NT = P0 / 64 + 4, tok0 = b * SEQ;
    constexpr int KBUF = SHM_K + SHM_KR, VOFF = 2 * KBUF, WOFF = VOFF + 3 * SHM_V;
    float* wsl = (float*)(lds + WOFF) + wid * 64; float* li_l = wsl; float* al_l = wsl + 32;
    char* QR_l = lds + WOFF + 2048 + wid * 4096 + lane * 16;
    const int qlo = P0 + wid * 32, qm = qlo + r32 - 4 * hi;
    const int qtok = tok0 + qlo + r32;
    bf16x8 qr[8];
    { bf16x8 qx[4];
      const bf16_t* qp = Q + (size_t)qtok * 1536 + h * 192 + hi * 8;
#pragma unroll
      for (int d0 = 0; d0 < 8; ++d0) qr[d0] = *(const bf16x8*)(qp + d0 * 16);
#pragma unroll
      for (int d0 = 0; d0 < 4; ++d0) qx[d0] = *(const bf16x8*)(qp + 128 + d0 * 16);
#pragma unroll
      for (int dd = 0; dd < 2; ++dd) {
          const int i0 = dd * 16 + hi * 8;
          const f32x4 c0 = *(const f32x4*)(ctab + (size_t)qtok * 32 + i0), c1 = *(const f32x4*)(ctab + (size_t)qtok * 32 + i0 + 4);
          const f32x4 s0 = *(const f32x4*)(stab + (size_t)qtok * 32 + i0), s1 = *(const f32x4*)(stab + (size_t)qtok * 32 + i0 + 4);
          f32x4 a0, a1, b0, b1;
#pragma unroll
          for (int e = 0; e < 4; ++e) {
              const float x1 = bf2f(qx[dd][e]), x2 = bf2f(qx[2 + dd][e]);
              a0[e] = x1 * c0[e] - x2 * s0[e]; b0[e] = x2 * c0[e] + x1 * s0[e];
              const float y1 = bf2f(qx[dd][4 + e]), y2 = bf2f(qx[2 + dd][4 + e]);
              a1[e] = y1 * c1[e] - y2 * s1[e]; b1[e] = y2 * c1[e] + y1 * s1[e];
          }
          *(bf16x8*)(QR_l + dd * 1024) = pack8(a0, a1); *(bf16x8*)(QR_l + (2 + dd) * 1024) = pack8(b0, b1);
      } }
    const int sr = tid >> 4, sc = (tid & 15) * 8, vst0 = v_st(sr, sc), vst1 = v_st(32 + sr, sc), kws = KSWZ(sr, sc * 2);
    const int rr = tid >> 3, rc = (tid & 7) * 8, krws = rr * 128 + ((rc * 2) ^ ((rr & 7) << 4));
    const int vbase = (int)(uintptr_t)lds + VOFF + v_rd_base(lane);
    const bf16_t* kvp = KV + (size_t)(tok0 + sr) * 2048 + h * 256 + sc;
    const bf16_t* krp = KR + (size_t)(tok0 + rr) * 64 + rc;
    bf16x8 st_k0, st_k1, st_v0, st_v1, st_kr;
#define LOADT(t) do { const bf16_t* p_ = kvp + (size_t)(t) * 64 * 2048; st_k0 = *(const bf16x8*)p_; st_v0 = *(const bf16x8*)(p_ + 128); \
        st_k1 = *(const bf16x8*)(p_ + 32 * 2048); st_v1 = *(const bf16x8*)(p_ + 32 * 2048 + 128); st_kr = *(const bf16x8*)(krp + (size_t)(t) * 64 * 64); } while (0)
#define WRITET(ko, vo) do { char* k_ = lds + (ko); char* v_ = lds + VOFF + (vo); *(bf16x8*)(k_ + kws) = st_k0; *(bf16x8*)(k_ + kws + 32 * 256) = st_k1; \
        *(bf16x8*)(v_ + vst0) = st_v0; *(bf16x8*)(v_ + vst1) = st_v1; *(bf16x8*)(k_ + SHM_K + krws) = st_kr; } while (0)
#define RESC(a) do { if (__any((a) < 1.f)) { if (hi == 0) al_l[r32] = (a); asm volatile("s_waitcnt lgkmcnt(0)" ::: "memory"); \
        _Pragma("unroll") for (int d_ = 0; d_ < 4; ++d_) _Pragma("unroll") for (int r = 0; r < 16; ++r) o[d_][r] *= al_l[crow(r, hi)]; } } while (0)
    float m_reg = -1e30f, l_reg = 0.f; f32x16 o[4] = {};
    f32x16 pA0 = f32x16{}, pA1 = f32x16{}, pB0 = f32x16{}, pB1 = f32x16{}; float mnA = 0.f, alA = 1.f, mnB = 0.f, alB = 1.f;
    bf16x8 pa0 = bf16x8{}, pa1 = bf16x8{}, pa2 = bf16x8{}, pa3 = bf16x8{};
    int vcur = 0, vprev = 2 * SHM_V;
#define STEP(PX0, PX1, mnX, alX, PY0, PY1, alY, t) do { \
        const int kcur_ = ((t) & 1) * KBUF, vnext_ = vcur == 2 * SHM_V ? 0 : vcur + SHM_V; \
        const int kb_ = (t) * 64; const bool actX_ = kb_ <= qlo + 31, actY_ = (t) > 0 && kb_ - 64 <= qlo + 31; \
        SBAR(); if (actX_) qkt(PX0, PX1, lds + kcur_, lds + kcur_ + SHM_K, QR_l, r32, hi, qr); \
        SBAR(); if ((t) + 1 < NT) { WRITET(KBUF - kcur_, vnext_); if ((t) + 2 < NT) LOADT((t) + 2); } SBAR();     \
        if (actY_) { finishSM(PY0, PY1, alY, l_reg, pa0, pa1, pa2, pa3); SBAR(); pv_tile(o, vbase + vprev, pa0, pa1, pa2, pa3); } \
        if (actX_) { if (kb_ + 63 > qlo) mask_tile(PX0, PX1, qm - kb_, 0x40000000u); partialSM(PX0, PX1, m_reg, mnX, alX); RESC(alX); } \
        vprev = vcur; vcur = vnext_; \
        __syncthreads(); } while (0)
    LOADT(0);
    __syncthreads();
    WRITET(0, 0);
    LOADT(1);
    __syncthreads();
    STEP(pA0, pA1, mnA, alA, pB0, pB1, alB, 0);
    for (int t = 1; t + 1 < NT; t += 2) {
        STEP(pB0, pB1, mnB, alB, pA0, pA1, alA, t);
        STEP(pA0, pA1, mnA, alA, pB0, pB1, alB, t + 1);
    }
    STEP(pB0, pB1, mnB, alB, pA0, pA1, alA, NT - 1);
    if ((NT - 1) * 64 <= qlo + 31) { finishSM(pB0, pB1, alB, l_reg, pa0, pa1, pa2, pa3); SBAR(); pv_tile(o, vbase + vprev, pa0, pa1, pa2, pa3); }
#undef STEP
#undef RESC
#undef WRITET
#undef LOADT
    if (hi == 0) li_l[r32] = l_reg; asm volatile("s_waitcnt lgkmcnt(0)" ::: "memory");
    bf16_t* Ow = O + (size_t)(tok0 + qlo) * 1024 + h * 128;
#pragma unroll
    for (int r = 0; r < 16; ++r) { const int orow = crow(r, hi); const float rli = __builtin_amdgcn_rcpf(li_l[orow]);
#pragma unroll
        for (int d0 = 0; d0 < 4; ++d0) { const float v = o[d0][r] * rli; const float vn = __shfl_xor(v, 1);
            if ((r32 & 1) == 0) *(unsigned*)(Ow + (size_t)orow * 1024 + d0 * 32 + r32) = cvtpk(v, vn); } }
}
__device__ __forceinline__ void attn_phase(const bf16_t* Q, const bf16_t* KV, const bf16_t* KR, const float* ctab, const float* stab, bf16_t* O, char* lds) {
    for (int L = blockIdx.x; L < 512; L += gridDim.x) {
        const int xcd = L & 7, k = L >> 3, bh = xcd * 8 + (k >> 3), x = k & 7;
        attn_qblock(Q, KV, KR, ctab, stab, O, bh >> 3, bh & 7, 15 - x, lds);
        attn_qblock(Q, KV, KR, ctab, stab, O, bh >> 3, bh & 7, x, lds);
    }
    __syncthreads();
}
}

__device__ __forceinline__ void cvt_phase(const Params& p, unsigned char* smem) {
    const int tid = opq_tid();
    unsigned char* ws = p.ws;
    constexpr int C_POOL = 8 * 8, C_MD = 2 * 72, C_UQ = 2 * 72, C_UKV = 2 * 32, C_WO = 2 * 128, C_G = 4 * 352;
    constexpr int TOTAL = C_POOL + C_MD + C_UQ + C_UKV + C_WO + 3 * C_G;
    for (int u = blockIdx.x; u < TOTAL; u += gridDim.x) {
        int r = u, mtx, ldsrc, lddst, ntl, kind = 0; const float* src; bf16_t* dst; const float* scale = nullptr; const float* kscale = nullptr;
        if (r < C_POOL) { mtx = r / 8; r %= 8; src = p.pool_w + (size_t)mtx * 65536; ldsrc = 256; dst = (bf16_t*)(ws + OFF_WPOOL) + (size_t)mtx * 65536; lddst = 256; ntl = 4; scale = p.pool_scale + mtx * 256; }
        else if ((r -= C_POOL) < C_MD) { mtx = r / 72; r %= 72; src = p.w_down + (size_t)mtx * 1024 * 576; ldsrc = 576; dst = (bf16_t*)(ws + OFF_WMD) + (size_t)mtx * 768 * 1024; lddst = 1024; ntl = 9; kind = 3; kscale = p.norm_mix + (2 * mtx + 1) * 1024; }
        else if ((r -= C_MD) < C_UQ) { mtx = r / 72; r %= 72; src = p.w_uq + (size_t)mtx * 384 * 1536; ldsrc = 1536; dst = (bf16_t*)(ws + OFF_WUQ) + (size_t)mtx * 1536 * 384; lddst = 384; ntl = 24; kscale = p.q_norm + mtx * 384; }
        else if ((r -= C_UQ) < C_UKV) { mtx = r / 32; r %= 32; src = p.w_ukv + (size_t)mtx * 128 * 2048; ldsrc = 2048; dst = (bf16_t*)(ws + OFF_WUKV) + (size_t)mtx * 2048 * 128; lddst = 128; ntl = 32; kscale = p.kv_norm + mtx * 128; }
        else if ((r -= C_UKV) < C_WO) { mtx = r / 128; r %= 128; src = p.w_o + (size_t)mtx * 1024 * 1024; ldsrc = 1024; dst = (bf16_t*)(ws + OFF_WO) + (size_t)mtx * 1024 * 1024; lddst = 1024; ntl = 16; }
        else if ((r -= C_WO) < C_G) { mtx = r / 352; r %= 352; src = p.w_gate + (size_t)mtx * 1024 * FF; ldsrc = FF; dst = (bf16_t*)(ws + OFF_WGU) + (size_t)mtx * 5632 * 1024; lddst = 1024; ntl = 44; kind = 1; kscale = p.norm_ffn + mtx * 1024; }
        else if ((r -= C_G) < C_G) { mtx = r / 352; r %= 352; src = p.w_up + (size_t)mtx * 1024 * FF; ldsrc = FF; dst = (bf16_t*)(ws + OFF_WGU) + (size_t)mtx * 5632 * 1024; lddst = 1024; ntl = 44; kind = 2; kscale = p.norm_ffn + mtx * 1024; }
        else { r -= C_G; mtx = r / 352; r %= 352; src = p.w_dn + (size_t)mtx * FF * 1024; ldsrc = 1024; dst = (bf16_t*)(ws + OFF_WDN) + (size_t)mtx * 1024 * FF; lddst = FF; ntl = 16; }
        const int k0 = (r / ntl) * 128 + (tid >> 6) * 16, ng = (r % ntl) * 64 + (tid & 63);
        float v[16];
#pragma unroll
        for (int i = 0; i < 16; ++i) v[i] = src[(size_t)(k0 + i) * ldsrc + ng];
        if (scale) { const float sc = scale[ng];
#pragma unroll
            for (int i = 0; i < 16; ++i) v[i] *= sc; }
        if (kscale) {
#pragma unroll
            for (int q = 0; q < 4; ++q) { const f32x4 kq = *(const f32x4*)(kscale + k0 + 4 * q);
#pragma unroll
                for (int i = 0; i < 4; ++i) v[4 * q + i] *= kq[i]; } }
        int drow = ng;
        if (kind == 1 || kind == 2) drow = (ng >> 7) * 256 + (ng & 127) + (kind == 2 ? 128 : 0);
        else if (kind == 3 && ng >= 512) { const int q = ng - 512, half = q >> 5, i2 = q & 31; drow = 512 + (i2 >> 4) * 32 + half * 16 + (i2 & 15); }
        u32x4 w0 = {cvtpk(v[0], v[1]), cvtpk(v[2], v[3]), cvtpk(v[4], v[5]), cvtpk(v[6], v[7])}, w1 = {cvtpk(v[8], v[9]), cvtpk(v[10], v[11]), cvtpk(v[12], v[13]), cvtpk(v[14], v[15])};
        *(u32x4*)(dst + (size_t)drow * lddst + k0) = w0; *(u32x4*)(dst + (size_t)drow * lddst + k0 + 8) = w1;
    }
    const int gt = blockIdx.x * 512 + tid, gn = gridDim.x * 512;
    unsigned zz = 0u; asm volatile("" : "+v"(zz)); const u32x4 z = {zz, zz, zz, zz};
    for (int i = gt; i < 2 * 192 * 128; i += gn) { const int l = i / (192 * 128), q = i % (192 * 128);
        *(u32x4*)((bf16_t*)(ws + OFF_WMD) + (size_t)l * 768 * 1024 + (size_t)576 * 1024 + (size_t)q * 8) = z; }
    float* ctab = (float*)(ws + OFF_CTAB); float* stab = (float*)(ws + OFF_STAB);
    for (int i = gt; i < T * 32; i += gn) { const int tok = i >> 5, j = i & 31;
        const float inv = 1.0f / exp2f((float)j * (13.287712379549449f / 32.0f));
        const float ang = (float)p.pos[tok] * inv;
        const double rev = (double)ang * 0.15915494309189535;
        const float fr = (float)(rev - rint(rev));
        ctab[i] = __builtin_amdgcn_cosf(fr); stab[i] = __builtin_amdgcn_sinf(fr); }
}

template <class TX>
__device__ __forceinline__ void norm_phase(const TX* x, const float* g, bf16_t* outb, float* outf) {
    const int tid = opq_tid(), lane = tid & 63, gw = blockIdx.x * 8 + (tid >> 6), nw = gridDim.x * 8;
    f32x4 gv[4];
#pragma unroll
    for (int i = 0; i < 4; ++i) gv[i] = *(const f32x4*)(g + (lane + 64 * i) * 4);
    int nw2 = nw; asm volatile("" : "+s"(nw2));
    for (int row = gw; row < T; row += 2 * nw2) {
        const int row2 = row + nw2 < T ? row + nw2 : row;
        const TX* xr = x + (size_t)row * 1024; const TX* xr2 = x + (size_t)row2 * 1024;
        f32x4 v[4], v2[4]; float ss = 0.f, ss2 = 0.f;
#pragma unroll
        for (int i = 0; i < 4; ++i) { v[i] = ld4(xr + (lane + 64 * i) * 4); v2[i] = ld4(xr2 + (lane + 64 * i) * 4); }
#pragma unroll
        for (int i = 0; i < 4; ++i) { ss += v[i][0] * v[i][0] + v[i][1] * v[i][1] + v[i][2] * v[i][2] + v[i][3] * v[i][3]; ss2 += v2[i][0] * v2[i][0] + v2[i][1] * v2[i][1] + v2[i][2] * v2[i][2] + v2[i][3] * v2[i][3]; }
        ss = wave_sum(ss); ss2 = wave_sum(ss2);
        const float rstd = rsqrtf(ss * (1.0f / 1024.0f) + EPS), rstd2 = rsqrtf(ss2 * (1.0f / 1024.0f) + EPS);
#pragma unroll
        for (int i = 0; i < 4; ++i) { const f32x4 y = v[i] * rstd * gv[i], y2 = v2[i] * rstd2 * gv[i];
            if (outb) { u32x2 w = {cvtpk(y[0], y[1]), cvtpk(y[2], y[3])}; *(u32x2*)(outb + (size_t)row * 1024 + (lane + 64 * i) * 4) = w;
                        u32x2 w2 = {cvtpk(y2[0], y2[1]), cvtpk(y2[2], y2[3])}; *(u32x2*)(outb + (size_t)row2 * 1024 + (lane + 64 * i) * 4) = w2; }
            else { *(f32x4*)(outf + (size_t)row * 1024 + (lane + 64 * i) * 4) = y; *(f32x4*)(outf + (size_t)row2 * 1024 + (lane + 64 * i) * 4) = y2; } }
    }
}

template <int WIN, class TX>
__device__ __forceinline__ void pool_rows(const TX* xc, const float* rs, float g0, float g1, bf16_t* Pc, int s0) {
    float2 h[31 + WIN];
#pragma unroll
    for (int i = 0; i < 31 + WIN; ++i) { const int j = i - (WIN - 1);
        if (s0 + j >= 0) { const float2 xv = ld2(xc + (ptrdiff_t)j * 1024); const float r = rs[16 + j]; h[i] = make_float2(xv.x * r * g0, xv.y * r * g1); }
        else h[i] = make_float2(0.f, 0.f); }
    float S0 = 0.f, S1 = 0.f;
#pragma unroll
    for (int i = 0; i < WIN - 1; ++i) { S0 += h[i].x; S1 += h[i].y; }
#pragma unroll
    for (int k = 0; k < 32; ++k) { const int i = k + WIN - 1, s = s0 + k; S0 += h[i].x; S1 += h[i].y;
        const int na = s + 1 < WIN ? s + 1 : WIN; const float inv = 1.0f / (float)na;
        *(unsigned*)(Pc + (size_t)k * 1024) = cvtpk(S0 * inv - h[i].x, S1 * inv - h[i].y);
        S0 -= h[k].x; S1 -= h[k].y; }
}
template <class TX>
__device__ __forceinline__ void poolnorm_phase(const TX* x, const float* g, bf16_t* P, const float* part, unsigned char* smem) {
    float* rs = (float*)smem;
    const int tid = opq_tid(), wid = tid >> 6, lane = tid & 63;
    const int c = tid * 2;
    const float g0 = g[c], g1 = g[c + 1];
    for (int tile = blockIdx.x; tile < T / 32; tile += gridDim.x) {
        const int t0 = tile * 32, s0 = t0 & (SEQ - 1);
        if (part) {
            if (tid < 48 && s0 - 16 + tid >= 0) { const f32x4* pp = (const f32x4*)(part + (size_t)(t0 - 16 + tid) * 16); float ss = 0.f;
#pragma unroll
                for (int i = 0; i < 4; ++i) { const f32x4 v = pp[i]; ss += (v[0] + v[1]) + (v[2] + v[3]); }
                rs[tid] = rsqrtf(ss * (1.0f / 1024.0f) + EPS); }
        } else
        { float ssq[6];
#pragma unroll
          for (int k = 0; k < 6; ++k) { const int rr = wid * 6 + k, s = s0 - 16 + rr; float ss = 0.f;
              if (s >= 0) { const TX* xr = x + (size_t)(t0 - 16 + rr) * 1024;
#pragma unroll
                  for (int i = 0; i < 4; ++i) { const f32x4 v = ld4(xr + (lane + 64 * i) * 4); ss += v[0] * v[0] + v[1] * v[1] + v[2] * v[2] + v[3] * v[3]; } }
              ssq[k] = ss; }
#pragma unroll
          for (int k = 0; k < 6; ++k) { const float ss = wave_sum(ssq[k]); if (lane == 0) rs[wid * 6 + k] = rsqrtf(ss * (1.0f / 1024.0f) + EPS); } }
        __syncthreads();
        { const TX* xc = x + (size_t)t0 * 1024 + c; bf16_t* Pc = P + (size_t)t0 * 1024 + c;
          const int grp = __builtin_amdgcn_readfirstlane(wid >> 1);
          if (grp == 0) pool_rows<2, TX>(xc, rs, g0, g1, Pc, s0); else if (grp == 1) pool_rows<4, TX>(xc, rs, g0, g1, Pc, s0);
          else if (grp == 2) pool_rows<8, TX>(xc, rs, g0, g1, Pc, s0); else pool_rows<16, TX>(xc, rs, g0, g1, Pc, s0); }
        __syncthreads();
    }
}

#define XB_TMO      128
#define XB_XCNT(j)  (256  + 64 * (j))
#define XB_XSUB(j)  (1280 + 64 * (j))
#define XB_XGEN(j)  (2304 + 64 * (j))
#define XB_TOP      3328
#define XB_TOPGEN   3392
#define XCD_BAR_WORDS 3456
#define XB_SPIN_CAP (1u << 18)

__device__ __forceinline__ unsigned xb_ld(unsigned* p)              { return __hip_atomic_load(p, __ATOMIC_RELAXED, __HIP_MEMORY_SCOPE_AGENT); }
__device__ __forceinline__ unsigned xb_add(unsigned* p, unsigned v) { return __hip_atomic_fetch_add(p, v, __ATOMIC_RELAXED, __HIP_MEMORY_SCOPE_AGENT); }
__device__ __forceinline__ unsigned xb_xcc_id() { return (unsigned)__builtin_amdgcn_s_getreg((3 << 11) | 20) & 0xFu; }
#define XB_SPIN(cond, bar) do { unsigned _sp = 0; while (cond) { __builtin_amdgcn_s_sleep(1); \
    if ((++_sp & 255u) == 0u) { if (xb_ld(&(bar)[XB_TMO])) break; if (_sp > XB_SPIN_CAP) { atomicAdd(&(bar)[XB_TMO], 1u); break; } } } } while (0)

struct XcdBarrier {
    unsigned* bar; unsigned x;
    volatile LAS unsigned* st;
};

__device__ __forceinline__ XcdBarrier xcd_barrier_post(unsigned* bar, volatile LAS unsigned* st) {
    XcdBarrier b; b.bar = bar; b.x = xb_xcc_id(); b.st = st;
    if (threadIdx.x == 0) (void)xb_add(&bar[XB_XCNT(b.x)], 1u);
    return b;
}
__device__ __forceinline__ void xcd_barrier_complete(unsigned* bar, unsigned x, unsigned& nloc, unsigned& nx) {
    const unsigned G = gridDim.x * gridDim.y * gridDim.z;
    unsigned sum, cnt, mine, sp = 0u;
    for (;;) {
        sum = 0u; cnt = 0u; mine = 0u;
#pragma unroll
        for (unsigned j = 0; j < 16; ++j) { const unsigned c = xb_ld(&bar[XB_XCNT(j)]); sum += c; cnt += (c > 0u) ? 1u : 0u; mine = (j == x) ? c : mine; }
        if (sum == G) break;
        __builtin_amdgcn_s_sleep(1);
        if ((++sp & 255u) == 0u) { if (xb_ld(&bar[XB_TMO])) break; if (sp > XB_SPIN_CAP) { atomicAdd(&bar[XB_TMO], 1u); break; } }
    }
    nloc = mine > 0u ? mine : 1u; nx = cnt > 0u ? cnt : 1u;
}

__device__ __forceinline__ void xcd_barrier(const XcdBarrier& b) {
    asm volatile("s_waitcnt vmcnt(0)" ::: "memory");
    __syncthreads();
    if (threadIdx.x == 0) {
        unsigned* bar = b.bar; asm volatile("" : "+s"(bar));
        __builtin_amdgcn_s_waitcnt(0);
        unsigned nloc = b.st[0], nx = b.st[1];
        if (nloc == 0u) { xcd_barrier_complete(bar, b.x, nloc, nx); b.st[0] = nloc; b.st[1] = nx; }
        const unsigned old = xb_add(&bar[XB_XSUB(b.x)], 1u);
        const unsigned gen = old / nloc;
        if (old + 1u == (gen + 1u) * nloc) {
            __builtin_amdgcn_fence(__ATOMIC_RELEASE, "agent");
            asm volatile("s_waitcnt vmcnt(0)" ::: "memory");
            const unsigned og = xb_add(&bar[XB_TOP], 1u);
            const unsigned tg = og / nx;
            if (og + 1u == (tg + 1u) * nx) xb_add(&bar[XB_TOPGEN], 1u);
            else XB_SPIN(xb_ld(&bar[XB_TOPGEN]) == tg, bar);
            __builtin_amdgcn_fence(__ATOMIC_ACQUIRE, "agent");
            xb_add(&bar[XB_XGEN(b.x)], 1u);
            asm volatile("s_waitcnt vmcnt(0)" ::: "memory");
        } else {
            XB_SPIN(xb_ld(&bar[XB_XGEN(b.x)]) == gen, bar);
            __builtin_amdgcn_fence(__ATOMIC_ACQUIRE, "agent");
            asm volatile("s_waitcnt vmcnt(0)" ::: "memory");
        }
    }
    __syncthreads();
}


enum { K_CVT = 0, K_NORM, K_POOLNORM, K_GEMM_MD, K_ATTN, K_GEMM_RESID, K_GEMM_GU, K_GEMM_BF16 };
constexpr int NSTEPS = 21;
#ifndef NRUN
#define NRUN NSTEPS
#endif

__global__ void __launch_bounds__(512, 2) mega(Params p) {
    extern __shared__ __attribute__((aligned(16))) unsigned char smem[];
    cg::grid_group grid = cg::this_grid();
    unsigned char* ws0 = p.ws;
    volatile LAS unsigned* xb_st = (volatile LAS unsigned*)((LAS unsigned char*)smem + 133120);
    if (threadIdx.x == 0) { xb_st[0] = 0u; xb_st[1] = 0u; xb_st[2] = 0u; xb_st[3] = 0u; }
    __syncthreads();
    (void)xcd_barrier_post((unsigned*)(ws0 + OFF_BAR), xb_st);
#define GRID_BARRIER() do { XcdBarrier b_; unsigned char* w_ = p.ws; asm volatile("" : "+s"(w_)); b_.bar = (unsigned*)(w_ + OFF_BAR); b_.x = xb_xcc_id(); \
        b_.st = (volatile LAS unsigned*)((LAS unsigned char*)smem + 133120); xcd_barrier(b_); } while (0)
    if (p.ph_hi > 1000) grid.sync();

#if MK_SINGLE
    constexpr int s_lo = 0, s_hi = NSTEPS;
#else
    const int s_lo = p.ph_lo, s_hi = p.ph_hi;
#endif
    for (int s = s_lo; s < s_hi; ++s) {
        const int kind = p.kind[s], layer = p.layer[s], sub = p.sub[s];
        unsigned char* ws = ws0; asm volatile("" : "+s"(ws));
        bf16_t* H = (bf16_t*)(ws + OFF_H);
        bf16_t* ACT = (bf16_t*)(ws + OFF_ACT);
        bf16_t* Db = (bf16_t*)(ws + OFF_D);
        bf16_t* Ob = (bf16_t*)(ws + OFF_O);
        bf16_t* KRb = (bf16_t*)(ws + OFF_KR);
        bf16_t* Qb = (bf16_t*)(ws + OFF_Q);
        bf16_t* KVb = (bf16_t*)(ws + OFF_KV);
        bf16_t* XB = (bf16_t*)(ws + OFF_XB);
        float* PARTX = (float*)(ws + OFF_PARTX); float* PARTD = (float*)(ws + OFF_PARTD);
        const float* ctab = (const float*)(ws + OFF_CTAB); const float* stab = (const float*)(ws + OFF_STAB);
        const int j = layer >> 1;
#pragma unroll 1
        for (int rep = 0; rep < ((((PROBE_MASK >> kind) & 1) && (kind != K_GEMM_RESID) && (kind != K_NORM || sub != 2)) ? PROBE_REPS : 1); ++rep) {
        switch (kind) {
        case K_CVT: cvt_phase(p, smem); __syncthreads(); poolnorm_phase<float>(p.x, p.norm_mix, H, nullptr, smem); break;
        case K_NORM: norm_phase<bf16_t>(XB, p.norm_final, nullptr, p.out); break;
        case K_POOLNORM: poolnorm_phase<bf16_t>(XB, p.norm_mix + layer * 1024, H, PARTX, smem); break;
        case K_ATTN: at::attn_phase(Qb, KVb, KRb, ctab, stab, Ob, (char*)smem); break;
        case K_GEMM_RESID: {
            pg8::Gemm g; pg8::EpiResid E;
            if (sub == 0) { g = pg8::Gemm{H, (const bf16_t*)(ws + OFF_WPOOL) + (size_t)j * 1024 * 256, T, 1024, 256, 1024, 256, 256}; E = pg8::EpiResid{layer == 0 ? p.x : nullptr, XB, PARTX}; }
            else if (sub == 2) { g = pg8::Gemm{Ob, (const bf16_t*)(ws + OFF_WO) + (size_t)j * 1024 * 1024, T, 1024, 1024, 1024, 1024, 0}; E = pg8::EpiResid{nullptr, XB, PARTX}; }
            else { g = pg8::Gemm{ACT, (const bf16_t*)(ws + OFF_WDN) + (size_t)layer * 1024 * FF, T, 1024, FF, FF, FF, 0}; E = pg8::EpiResid{nullptr, XB, PARTX}; }
            pg8::StaticOrder S; S.init(g.M, g.N, (int)gridDim.x, opq_bid());
            pg8::gemm_phase<pg8::EpiResid>((LAS unsigned char*)smem, g, S, E);
        } break;
        case K_GEMM_MD: {
            pg8::Gemm g{XB, (const bf16_t*)(ws + OFF_WMD) + (size_t)j * 768 * 1024, T, 768, 1024, 1024, 1024, 0};
            pg8::EpiMdown E{Db, KRb, PARTX, PARTD, ctab, stab};
            pg8::StaticOrder S; S.init(g.M, g.N, (int)gridDim.x, opq_bid());
            pg8::gemm_phase<pg8::EpiMdown>((LAS unsigned char*)smem, g, S, E);
        } break;
        case K_GEMM_GU: {
            pg8::Gemm g{XB, (const bf16_t*)(ws + OFF_WGU) + (size_t)layer * 5632 * 1024, T, 5632, 1024, 1024, 1024, 0};
            pg8::EpiSwiglu E{ACT, FF, PARTX, (LAS float*)((LAS unsigned char*)smem + 131072)};
            pg8::StaticOrder S; S.init(g.M, g.N, (int)gridDim.x, opq_bid());
            pg8::gemm_phase<pg8::EpiSwiglu>((LAS unsigned char*)smem, g, S, E);
        } break;
        case K_GEMM_BF16: {
#pragma unroll 1
            for (int w = 0; w < 2; ++w) {
                pg8::Gemm g; pg8::EpiBf16 E;
                if (w == 0) { g = pg8::Gemm{Db, (const bf16_t*)(ws + OFF_WUQ) + (size_t)j * 1536 * 384, T, 1536, 384, 640, 384, 0}; E = pg8::EpiBf16{Qb, 1536, PARTD, 0, 2, 1.0f / 384.0f}; }
                else { g = pg8::Gemm{Db + 384, (const bf16_t*)(ws + OFF_WUKV) + (size_t)j * 2048 * 128, T, 2048, 128, 640, 128, 0}; E = pg8::EpiBf16{KVb, 2048, PARTD, 8, 1, 1.0f / 128.0f}; }
                pg8::StaticOrder S; S.init(g.M, g.N, (int)gridDim.x, opq_bid());
                pg8::gemm_phase<pg8::EpiBf16>((LAS unsigned char*)smem, g, S, E);
            }
        } break;
        default: break;
        }
        if (rep + 1 < ((((PROBE_MASK >> kind) & 1) && (kind != K_GEMM_RESID) && (kind != K_NORM || sub != 2)) ? PROBE_REPS : 1)) GRID_BARRIER();
        }
        if (s + 1 < s_hi) GRID_BARRIER();
    }
}


extern "C" void kernel_launch(void* const* d_in, const int* in_sizes, int n_in, void* d_out, int out_size, void* d_ws, size_t ws_size, hipStream_t stream) {
    static int grid_blocks = 0;
    if (grid_blocks == 0) {
        if (n_in != 16 || in_sizes[0] != T * DM || out_size != T * DM || ws_size < WS_END) {
            fprintf(stderr, "kernel_launch: unexpected shapes (n_in %d, in0 %d, out %d, ws %zu, need %zu)\n", n_in, n_in > 0 ? in_sizes[0] : -1, out_size, ws_size, (size_t)WS_END);
            grid_blocks = -1; return; }
        int dev = 0, cus = 0, per_cu = 0;
        (void)hipGetDevice(&dev);
        if (hipDeviceGetAttribute(&cus, hipDeviceAttributeMultiprocessorCount, dev) != hipSuccess || cus <= 0) cus = 256;
        if (hipFuncSetAttribute((const void*)mega, hipFuncAttributeMaxDynamicSharedMemorySize, LDS_BYTES) != hipSuccess) fprintf(stderr, "kernel_launch: hipFuncSetAttribute failed\n");
        if (hipOccupancyMaxActiveBlocksPerMultiprocessor(&per_cu, (const void*)mega, 512, LDS_BYTES) != hipSuccess || per_cu < 1) { fprintf(stderr, "kernel_launch: occupancy query gave %d\n", per_cu); per_cu = 1; }
        (void)hipGetLastError();
        grid_blocks = cus * per_cu;
    }
    if (grid_blocks < 0) return;
    Params p{};
    p.x = (const float*)d_in[0]; p.pos = (const int*)d_in[1]; p.norm_mix = (const float*)d_in[2]; p.norm_ffn = (const float*)d_in[3]; p.norm_final = (const float*)d_in[4];
    p.pool_w = (const float*)d_in[5]; p.pool_scale = (const float*)d_in[6]; p.w_down = (const float*)d_in[7]; p.q_norm = (const float*)d_in[8]; p.w_uq = (const float*)d_in[9];
    p.kv_norm = (const float*)d_in[10]; p.w_ukv = (const float*)d_in[11]; p.w_o = (const float*)d_in[12]; p.w_gate = (const float*)d_in[13]; p.w_up = (const float*)d_in[14]; p.w_dn = (const float*)d_in[15];
    p.out = (float*)d_out; p.ws = (unsigned char*)d_ws;
    { int n = 0;
#define ADD(k, l, sb) do { p.kind[n] = (unsigned char)(k); p.layer[n] = (unsigned char)(l); p.sub[n] = (unsigned char)(sb); ++n; } while (0)
      ADD(K_CVT, 0, 0);
      for (int l = 0; l < 4; ++l) {
          if ((l & 1) == 0) { if (l > 0) ADD(K_POOLNORM, l, 0); ADD(K_GEMM_RESID, l, 0); }
          else { ADD(K_GEMM_MD, l, 0); ADD(K_GEMM_BF16, l, 0); ADD(K_ATTN, l, 0); ADD(K_GEMM_RESID, l, 2); }
          ADD(K_GEMM_GU, l, 0); ADD(K_GEMM_RESID, l, 3);
      }
      ADD(K_NORM, 0, 2);
#undef ADD
      if (n != NSTEPS) fprintf(stderr, "kernel_launch: step program has %d steps, expected %d\n", n, NSTEPS); }
#if MK_SINGLE
    p.ph_lo = 0; p.ph_hi = NSTEPS;
    (void)hipMemsetAsync((char*)d_ws + OFF_BAR, 0, 16384, stream);
    void* args[] = {&p};
    hipError_t e = hipLaunchCooperativeKernel((const void*)mega, dim3(grid_blocks), dim3(512), args, LDS_BYTES, stream);
    if (e != hipSuccess) fprintf(stderr, "cooperative launch failed: %s (grid %d)\n", hipGetErrorString(e), grid_blocks);
#else
    for (int s = 0; s < NRUN; ++s) {
        p.ph_lo = s; p.ph_hi = s + 1;
        hipLaunchKernelGGL(mega, dim3(grid_blocks), dim3(512), LDS_BYTES, stream, p);
    }
#endif
}
```
